# Optimizing an MI355X kernel written in HIP

```python
import math
import jax, jax.numpy as jnp
from jax import lax
import numpy as np

D_MODEL = 2048
BATCH = 1
SEQ = 16384
DEPTH = 4

GRID_W = 64
CTX_LEN = 256
N_GROUPS = 4
GROUP_WIDTH = D_MODEL // N_GROUPS
D_MIX = N_GROUPS * GROUP_WIDTH
HEAD_DIM = 64
QBLOCK = 128
A_DH = HEAD_DIM
A_HEADS = GROUP_WIDTH // (2 * A_DH)
B_GDIM = 128
B_GROUPS = GROUP_WIDTH // B_GDIM
CHUNK = 128
C_DH = HEAD_DIM
C_HEADS = GROUP_WIDTH // C_DH
C_KV_HEADS = C_HEADS // 4
WINDOW = 128
D_DH = HEAD_DIM
D_HEADS = GROUP_WIDTH // D_DH
NA_ROWS = 8
NA_COLS = 16
D_FF = 256 * math.ceil(8 * D_MODEL / 3 / 256)
N_MOD = 9
ROPE_THETA = 10000.0
LN_EPS = 1e-6
NEG_INF = -1e30
DEEPNORM_ALPHA = (2 * DEPTH) ** 0.25
DEEPNORM_BETA = (8 * DEPTH) ** -0.25
PROJ_SPLITS = (GROUP_WIDTH, GROUP_WIDTH, GROUP_WIDTH,
               GROUP_WIDTH, GROUP_WIDTH,
               GROUP_WIDTH, C_KV_HEADS * C_DH, C_KV_HEADS * C_DH,
               GROUP_WIDTH, GROUP_WIDTH, GROUP_WIDTH)
D_PROJ = sum(PROJ_SPLITS)

kernel_name = 'hybrid_parallel_group_flow_block'


def layer_norm(t, g, b):
    tf = t.astype(jnp.float32)
    tc = tf - jnp.mean(tf, axis=-1, keepdims=True)
    var = jnp.mean(tc * tc, axis=-1, keepdims=True)
    return (tc * lax.rsqrt(var + LN_EPS) * g.astype(jnp.float32) + b.astype(jnp.float32)).astype(t.dtype)


def rms_norm(t):
    tf = t.astype(jnp.float32)
    return (tf * lax.rsqrt(jnp.mean(tf * tf, axis=-1, keepdims=True) + LN_EPS)).astype(t.dtype)


def modulate(t, shift, scale):
    return t * (1.0 + scale) + shift


def swiglu(h, w_in, w_out):
    gate, up = jnp.split(h @ w_in, 2, axis=-1)
    return (jax.nn.silu(gate) * up) @ w_out


def axial_rope_tables(n_tokens, head_dim):
    t = jnp.arange(n_tokens, dtype=jnp.int32)
    row = (t // GRID_W).astype(jnp.float32)
    col = (t % GRID_W).astype(jnp.float32)
    n_freq = head_dim // 4
    inv = ROPE_THETA ** (-jnp.arange(n_freq, dtype=jnp.float32) / n_freq)
    ang = jnp.concatenate([row[:, None] * inv, col[:, None] * inv], axis=-1)
    return jnp.cos(ang), jnp.sin(ang)


def apply_rope(t, cos, sin):
    half = t.shape[-1] // 2
    shape = (1, cos.shape[0]) + (1,) * (t.ndim - 3) + (half,)
    cs, sn = cos.reshape(shape), sin.reshape(shape)
    t1 = t[..., :half].astype(jnp.float32)
    t2 = t[..., half:].astype(jnp.float32)
    return jnp.concatenate([t1 * cs - t2 * sn, t1 * sn + t2 * cs], axis=-1).astype(t.dtype)


def diff_attention(q, k, v, lam):
    s = jnp.einsum('bqhcd,bkhcd->bhcqk', q, k).astype(jnp.float32) * (A_DH ** -0.5)
    p = jax.nn.softmax(s, axis=-1)
    a = p[:, :, 0] - lam * p[:, :, 1]
    return jnp.einsum('bhqk,bkhe->bqhe', a.astype(v.dtype), v)


def diff_attention_latent(q, k, v, kc, vc, lam):
    Bn, N = q.shape[:2]
    nb = N // QBLOCK
    k_all = jnp.concatenate([kc, k], axis=1)
    v_all = jnp.concatenate([vc, v], axis=1)
    qb = jnp.moveaxis(q.reshape((Bn, nb, QBLOCK) + q.shape[2:]), 1, 0)
    ob = lax.map(lambda qi: diff_attention(qi, k_all, v_all, lam), qb)
    return jnp.moveaxis(ob, 0, 1).reshape((Bn, N) + v.shape[2:])


def spatial_gating(u, v, gn_g, gn_b, w_s, b_s):
    Bn, N = u.shape[:2]
    u = jax.nn.gelu(u)
    v = layer_norm(jax.nn.gelu(v), gn_g, gn_b)
    vch = v.reshape(Bn, N // CHUNK, CHUNK, B_GROUPS, B_GDIM)
    mixed = jnp.einsum('gpq,bnqgc->bnpgc', w_s, vch) + jnp.swapaxes(b_s, 0, 1)[None, None, :, :, None]
    return u * mixed.reshape(Bn, N, GROUP_WIDTH)


def sink_softmax(sink, s):
    grp = C_HEADS // C_KV_HEADS
    sb = jnp.broadcast_to(sink.astype(jnp.float32).reshape(C_KV_HEADS, grp, 1, 1), s.shape[:-1] + (1,))
    return jax.nn.softmax(jnp.concatenate([sb, s], axis=-1), axis=-1)[..., 1:]


def window_attention_latent(q, k, v, kc, vc, sink):
    Bn, N = q.shape[:2]
    L = kc.shape[1]
    nb = N // QBLOCK
    grp = C_HEADS // C_KV_HEADS
    qb = q.reshape(Bn, nb, QBLOCK, C_KV_HEADS, grp, C_DH)

    def band(t):
        tb = t.reshape(Bn, nb, QBLOCK, C_KV_HEADS, C_DH)
        tp = jnp.pad(tb, ((0, 0), (1, 1), (0, 0), (0, 0), (0, 0)))
        return jnp.concatenate([tp[:, :-2], tp[:, 1:-1], tp[:, 2:]], axis=2)

    kb, vb = band(k), band(v)
    scale = C_DH ** -0.5
    s_loc = jnp.einsum('bnqkgd,bnskd->bnkgqs', qb, kb).astype(jnp.float32) * scale
    s_ctx = jnp.einsum('bnqkgd,bskd->bnkgqs', qb, kc).astype(jnp.float32) * scale
    blk = jnp.arange(nb)[:, None, None]
    qpos = blk * QBLOCK + jnp.arange(QBLOCK)[None, :, None]
    kpos = (blk - 1) * QBLOCK + jnp.arange(3 * QBLOCK)[None, None, :]
    valid = (jnp.abs(kpos - qpos) <= WINDOW) & (kpos >= 0) & (kpos < N)
    s_loc = jnp.where(valid[None, :, None, None], s_loc, NEG_INF)
    p = sink_softmax(sink, jnp.concatenate([s_ctx, s_loc], axis=-1))
    p_ctx = p[..., :L].astype(v.dtype)
    p_loc = p[..., L:].astype(v.dtype)
    o = (jnp.einsum('bnkgqs,bskd->bnqkgd', p_ctx, vc)
         + jnp.einsum('bnkgqs,bnskd->bnqkgd', p_loc, vb))
    return o.reshape(Bn, N, C_HEADS * C_DH)


def sink_attention_ctx(qc, kc, vc, sink):
    Bn, L = qc.shape[:2]
    qg = qc.reshape(Bn, L, C_KV_HEADS, C_HEADS // C_KV_HEADS, C_DH)
    s = jnp.einsum('bqkgd,bskd->bkgqs', qg, kc).astype(jnp.float32) * (C_DH ** -0.5)
    p = sink_softmax(sink, s).astype(vc.dtype)
    return jnp.einsum('bkgqs,bskd->bqkgd', p, vc).reshape(Bn, L, C_HEADS * C_DH)


def neighbourhood_attention_latent(q, k, v, kc, vc, rpb):
    Bn, N = q.shape[:2]
    L = kc.shape[1]
    R = N // GRID_W
    kr = min(NA_ROWS, R)
    qg = q.reshape(Bn, R, GRID_W, D_HEADS, D_DH)
    kg = k.reshape(Bn, R, GRID_W, D_HEADS, D_DH)
    vg = v.reshape(Bn, R, GRID_W, D_HEADS, D_DH)
    r = jnp.arange(R)
    rs = jnp.clip(r - kr // 2, 0, R - kr)
    rows = rs[:, None] + jnp.arange(kr)[None, :]
    kn = kg[:, rows]
    vn = vg[:, rows]
    scale = D_DH ** -0.5
    s_nb = jnp.einsum('brqhd,brjkhd->brhqjk', qg, kn).astype(jnp.float32) * scale
    cq = jnp.arange(GRID_W)
    cs = jnp.clip(cq - NA_COLS // 2, 0, GRID_W - NA_COLS)
    col_ok = (cq[None, :] >= cs[:, None]) & (cq[None, :] < cs[:, None] + NA_COLS)
    dr = rows - r[:, None] + (NA_ROWS - 1)
    dc = jnp.clip(cq[None, :] - cq[:, None], -(NA_COLS - 1), NA_COLS - 1) + (NA_COLS - 1)
    bias = rpb[:, dr[:, None, :, None], dc[None, :, None, :]]
    bias = jnp.moveaxis(bias, 0, 1).astype(jnp.float32)
    s_nb = jnp.where(col_ok[:, None, :], s_nb + bias[None], NEG_INF)
    s_nb = s_nb.reshape(Bn, R, D_HEADS, GRID_W, kr * GRID_W)
    s_ctx = jnp.einsum('brqhd,bshd->brhqs', qg, kc).astype(jnp.float32) * scale
    p = jax.nn.softmax(jnp.concatenate([s_ctx, s_nb], axis=-1), axis=-1)
    p_ctx = p[..., :L].astype(v.dtype)
    p_nb = p[..., L:].reshape(Bn, R, D_HEADS, GRID_W, kr, GRID_W).astype(v.dtype)
    o = (jnp.einsum('brhqs,bshd->brqhd', p_ctx, vc)
         + jnp.einsum('brhqjk,brjkhd->brqhd', p_nb, vn))
    return o.reshape(Bn, N, D_HEADS * D_DH)


def ctx_attention(qc, kc, vc):
    Bn, L = qc.shape[:2]
    s = jnp.einsum('bqhd,bshd->bhqs', qc, kc).astype(jnp.float32) * (D_DH ** -0.5)
    p = jax.nn.softmax(s, axis=-1).astype(vc.dtype)
    return jnp.einsum('bhqs,bshd->bqhd', p, vc).reshape(Bn, L, D_HEADS * D_DH)


def token_mixer(h, hc, w_in, w_out, lam_vecs, lam_init, gn_g, gn_b, w_s, b_s, sink, rpb, cos, sin, need_ctx):
    Bn, N, _ = h.shape
    L = hc.shape[1]
    cuts = np.cumsum(PROJ_SPLITS)[:-1].tolist()
    aq, ak, av, bu, bv, cq, ck, cv, dq, dk, dv = jnp.split(h @ w_in, cuts, axis=-1)
    aqc, akc, avc, buc, bvc, cqc, ckc, cvc, dqc, dkc, dvc = jnp.split(hc @ w_in, cuts, axis=-1)

    lv = lam_vecs.astype(jnp.float32)
    lam = jnp.exp(jnp.sum(lv[0] * lv[1])) - jnp.exp(jnp.sum(lv[2] * lv[3])) + lam_init
    qa = apply_rope(aq.reshape(Bn, N, A_HEADS, 2, A_DH), cos, sin)
    ka = apply_rope(ak.reshape(Bn, N, A_HEADS, 2, A_DH), cos, sin)
    va = av.reshape(Bn, N, A_HEADS, 2 * A_DH)
    kac = akc.reshape(Bn, L, A_HEADS, 2, A_DH)
    vac = avc.reshape(Bn, L, A_HEADS, 2 * A_DH)
    ya = diff_attention_latent(qa, ka, va, kac, vac, lam)
    ya = (rms_norm(ya) * (1.0 - lam_init)).reshape(Bn, N, GROUP_WIDTH)

    yb = spatial_gating(bu, bv, gn_g, gn_b, w_s, b_s)

    qcq = apply_rope(cq.reshape(Bn, N, C_HEADS, C_DH), cos, sin)
    kcq = apply_rope(ck.reshape(Bn, N, C_KV_HEADS, C_DH), cos, sin)
    vcq = cv.reshape(Bn, N, C_KV_HEADS, C_DH)
    kcc = ckc.reshape(Bn, L, C_KV_HEADS, C_DH)
    vcc = cvc.reshape(Bn, L, C_KV_HEADS, C_DH)
    yc = window_attention_latent(qcq, kcq, vcq, kcc, vcc, sink)

    kdc = dkc.reshape(Bn, L, D_HEADS, D_DH)
    vdc = dvc.reshape(Bn, L, D_HEADS, D_DH)
    yd = neighbourhood_attention_latent(dq.reshape(Bn, N, D_HEADS, D_DH), dk.reshape(Bn, N, D_HEADS, D_DH),
                                        dv.reshape(Bn, N, D_HEADS, D_DH), kdc, vdc, rpb)

    y = jnp.concatenate([ya, yb, yc, yd], axis=-1) @ w_out
    if not need_ctx:
        return y, None

    ya_c = diff_attention(aqc.reshape(Bn, L, A_HEADS, 2, A_DH), kac, vac, lam)
    ya_c = (rms_norm(ya_c) * (1.0 - lam_init)).reshape(Bn, L, GROUP_WIDTH)
    yb_c = spatial_gating(buc, bvc, gn_g, gn_b, w_s, b_s)
    yc_c = sink_attention_ctx(cqc.reshape(Bn, L, C_HEADS, C_DH), kcc, vcc, sink)
    yd_c = ctx_attention(dqc.reshape(Bn, L, D_HEADS, D_DH), kdc, vdc)
    y_ctx = jnp.concatenate([ya_c, yb_c, yc_c, yd_c], axis=-1) @ w_out
    return y, y_ctx


def setup_inputs(seed: int = 0) -> dict:
    key = jax.random.key(seed)
    ks = jax.random.split(key, 24)

    def nrm(k, shape, scale):
        return jax.random.normal(k, shape, jnp.float32) * scale

    return {
        'x': nrm(ks[0], (BATCH, SEQ, D_MODEL), 1.0),
        'c': nrm(ks[1], (BATCH, D_MODEL), 1.0),
        'ctx': nrm(ks[2], (BATCH, CTX_LEN, D_MODEL), 1.0),
        'c_ctx': nrm(ks[3], (D_MODEL,), 1.0),
        'w_mod': nrm(ks[4], (DEPTH, D_MODEL, N_MOD * D_MODEL), D_MODEL ** -0.5),
        'b_mod': nrm(ks[5], (DEPTH, N_MOD * D_MODEL), 0.02),
        'ln_g': 1.0 + nrm(ks[6], (DEPTH, 3, D_MODEL), 0.02),
        'ln_b': nrm(ks[7], (DEPTH, 3, D_MODEL), 0.02),
        'ffn1_w_in': nrm(ks[8], (DEPTH, D_MODEL, 2 * D_FF), D_MODEL ** -0.5),
        'ffn1_w_out': nrm(ks[9], (DEPTH, D_FF, D_MODEL), D_FF ** -0.5 * DEEPNORM_BETA),
        'ffn2_w_in': nrm(ks[10], (DEPTH, D_MODEL, 2 * D_FF), D_MODEL ** -0.5),
        'ffn2_w_out': nrm(ks[11], (DEPTH, D_FF, D_MODEL), D_FF ** -0.5 * DEEPNORM_BETA),
        'mix_w_in': nrm(ks[12], (DEPTH, D_MODEL, D_PROJ), D_MODEL ** -0.5),
        'mix_w_out': nrm(ks[13], (DEPTH, D_MIX, D_MODEL), D_MIX ** -0.5 * DEEPNORM_BETA),
        'a_lambda': nrm(ks[14], (DEPTH, 4, A_DH), 0.1),
        'b_norm_g': 1.0 + nrm(ks[15], (DEPTH, GROUP_WIDTH), 0.02),
        'b_norm_b': nrm(ks[16], (DEPTH, GROUP_WIDTH), 0.02),
        'b_spatial_w': nrm(ks[17], (DEPTH, B_GROUPS, CHUNK, CHUNK), CHUNK ** -0.5),
        'b_spatial_b': 1.0 + nrm(ks[18], (DEPTH, B_GROUPS, CHUNK), 0.02),
        'c_sink': nrm(ks[19], (DEPTH, C_HEADS), 0.5),
        'd_rpb': nrm(ks[20], (DEPTH, D_HEADS, 2 * NA_ROWS - 1, 2 * NA_COLS - 1), 0.1),
    }


def reference(x, c, ctx, c_ctx, w_mod, b_mod, ln_g, ln_b, ffn1_w_in, ffn1_w_out, ffn2_w_in, ffn2_w_out,
              mix_w_in, mix_w_out, a_lambda, b_norm_g, b_norm_b, b_spatial_w, b_spatial_b, c_sink, d_rpb):
    N = x.shape[1]
    cos, sin = axial_rope_tables(N, HEAD_DIM)
    xc = ctx
    for l in range(DEPTH):
        last = l == DEPTH - 1
        lam_init = 0.8 - 0.6 * math.exp(-0.3 * l)
        mx = jnp.split((jax.nn.silu(c) @ w_mod[l] + b_mod[l])[:, None, :], N_MOD, axis=-1)
        mc = jnp.split((jax.nn.silu(c_ctx) @ w_mod[l] + b_mod[l])[None, None, :], N_MOD, axis=-1)

        x = layer_norm(DEEPNORM_ALPHA * x + 0.5 * mx[2] * swiglu(modulate(x, mx[0], mx[1]), ffn1_w_in[l], ffn1_w_out[l]),
                       ln_g[l, 0], ln_b[l, 0])
        xc = layer_norm(DEEPNORM_ALPHA * xc + 0.5 * mc[2] * swiglu(modulate(xc, mc[0], mc[1]), ffn1_w_in[l], ffn1_w_out[l]),
                        ln_g[l, 0], ln_b[l, 0])

        y, y_ctx = token_mixer(modulate(x, mx[3], mx[4]), modulate(xc, mc[3], mc[4]), mix_w_in[l], mix_w_out[l],
                               a_lambda[l], lam_init, b_norm_g[l], b_norm_b[l], b_spatial_w[l], b_spatial_b[l],
                               c_sink[l], d_rpb[l], cos, sin, not last)
        x = layer_norm(DEEPNORM_ALPHA * x + mx[5] * y, ln_g[l, 1], ln_b[l, 1])

        x = layer_norm(DEEPNORM_ALPHA * x + 0.5 * mx[8] * swiglu(modulate(x, mx[6], mx[7]), ffn2_w_in[l], ffn2_w_out[l]),
                       ln_g[l, 2], ln_b[l, 2])
        if not last:
            xc = layer_norm(DEEPNORM_ALPHA * xc + mc[5] * y_ctx, ln_g[l, 1], ln_b[l, 1])
            xc = layer_norm(DEEPNORM_ALPHA * xc + 0.5 * mc[8] * swiglu(modulate(xc, mc[6], mc[7]), ffn2_w_in[l], ffn2_w_out[l]),
                            ln_g[l, 2], ln_b[l, 2])
    return x
```

```cpp
#include <hip/hip_runtime.h>
#include <hip/hip_bf16.h>
#include <cstdio>
#include <cstdint>
#include <cmath>
namespace pg8 {
#define PG8_LAS __attribute__((address_space(3)))
typedef unsigned short bf16_t;
typedef short bf16x8 __attribute__((ext_vector_type(8)));
typedef float f32x4 __attribute__((ext_vector_type(4)));
typedef unsigned u32x4 __attribute__((ext_vector_type(4)));
constexpr int BM = 256, BK = 64, HALF = 128, HTB = HALF * BK * 2  , STAGE_BYTES = 8 * HTB, NXCD = 8, WGM = 8;

__host__ __device__ __forceinline__ int lds_byte(int r, int c) { const int st = (r >> 4) * 2 + (c >> 5), rr = r & 15, cc = c & 31, ob = rr * 64 + cc * 2; return st * 1024 + (ob ^ (((ob >> 9) & 1) << 5)); }
__host__ __device__ __forceinline__ void stage_rc(int b, int& R, int& C) { const int st = b / 1024, sb = b % 1024, swz = sb ^ (((sb >> 9) & 1) << 5); R = (st >> 1) * 16 + swz / 64; C = (st & 1) * 32 + (swz % 64) / 2; }
__host__ __device__ __forceinline__ int perm32(int rho) { const int n = rho >> 4, i = rho & 15; return 8 * (i >> 2) + 4 * n + (i & 3); }

struct Unit { int pm, pn; };
struct Gemm { const bf16_t* A; const bf16_t* Bt; int M, N, K; };

struct StaticOrder {
    int nM, nN, nwg, G, c;
    __host__ __device__ void init(int M, int N, int G_, int c_) { nM = M / BM; nN = N / BM; nwg = nM * nN; G = G_; c = c_; }
    __host__ __device__ bool next(int i, Unit& u) const {
        const long L = (long)i * G + c; if (L >= nwg) return false;
        int wgid = (int)L; { const int q = nwg / NXCD, r = nwg % NXCD, xcd = wgid % NXCD, off = wgid / NXCD; wgid = (xcd < r ? xcd * (q + 1) : r * (q + 1) + (xcd - r) * q) + off; }
        const int nig = WGM * nN, gid = wgid / nig, fm = gid * WGM, gsz = (nM - fm) < WGM ? (nM - fm) : WGM;
        u.pm = fm + ((wgid % nig) % gsz); u.pn = (wgid % nig) / gsz; return true;
    }
    __device__ __forceinline__ void a_ready(const Unit&) const {}
    __device__ __forceinline__ void done(const Unit&) const {}
};

__device__ __forceinline__ unsigned cvt_pk_bf16(float lo, float hi) { unsigned r; asm volatile("v_cvt_pk_bf16_f32 %0, %1, %2" : "=v"(r) : "v"(lo), "v"(hi)); return r; }
typedef float f32x2 __attribute__((ext_vector_type(2)));
__device__ __forceinline__ float silu_f(float x) { return x * __builtin_amdgcn_rcpf(1.0f + __builtin_amdgcn_exp2f(-1.4426950408889634f * x)); }
__device__ __forceinline__ float gelu_tanh_f(float x) { const float z2 = -2.0f * 1.4426950408889634f * 0.7978845608028654f * (x + 0.044715f * x * x * x); return x * __builtin_amdgcn_rcpf(1.0f + __builtin_amdgcn_exp2f(z2)); }

struct EpiSwiGLU {
    static constexpr bool PERM = true, AFTER_DRAIN = false;
    bf16_t* H; int ldh;
    __device__ __forceinline__ void operator()(const f32x4 (&acc)[2][2][4][2], const Unit& u, int wr, int wc, int fr, int fq) const {
        const int row0 = u.pm * BM + wr * 64 + fr, col0 = u.pn * HALF + wc * 32 + 8 * fq;
#pragma unroll
        for (int ai = 0; ai < 2; ++ai)
#pragma unroll
            for (int m = 0; m < 4; ++m) { bf16_t* rowp = H + (size_t)(row0 + ai * HALF + m * 16) * ldh + col0;
                const f32x4 g0 = acc[ai][0][m][0], g1 = acc[ai][0][m][1], u0 = acc[ai][1][m][0], u1 = acc[ai][1][m][1];
                u32x4 w;
                w.x = cvt_pk_bf16(silu_f(g0[0]) * u0[0], silu_f(g0[1]) * u0[1]); w.y = cvt_pk_bf16(silu_f(g0[2]) * u0[2], silu_f(g0[3]) * u0[3]);
                w.z = cvt_pk_bf16(silu_f(g1[0]) * u1[0], silu_f(g1[1]) * u1[1]); w.w = cvt_pk_bf16(silu_f(g1[2]) * u1[2], silu_f(g1[3]) * u1[3]);
                *(u32x4*)rowp = w; }
    }
};

struct EpiRes {
    static constexpr bool PERM = false, AFTER_DRAIN = false;
    float* X; int ldx; const float* gate_lat; const float* gate_ctx; float gscale, alpha; int ctx_pm;
    __device__ __forceinline__ void operator()(const f32x4 (&acc)[2][2][4][2], const Unit& u, int wr, int wc, int fr, int fq) const {
        const float* gp = (u.pm >= ctx_pm) ? gate_ctx : gate_lat;
        const int col0 = u.pn * BM + wc * 32 + 4 * fq;
        f32x4 gv[2][2];
#pragma unroll
        for (int bj = 0; bj < 2; ++bj)
#pragma unroll
            for (int n = 0; n < 2; ++n) gv[bj][n] = *(const f32x4*)(gp + col0 + bj * HALF + n * 16) * gscale;
#pragma unroll
        for (int ai = 0; ai < 2; ++ai)
#pragma unroll
            for (int m = 0; m < 4; ++m) { float* xp = X + (size_t)(u.pm * BM + ai * HALF + wr * 64 + m * 16 + fr) * ldx + col0;
#pragma unroll
                for (int bj = 0; bj < 2; ++bj)
#pragma unroll
                    for (int n = 0; n < 2; ++n) { f32x4 x = *(const f32x4*)(xp + bj * HALF + n * 16); x = x * alpha + gv[bj][n] * acc[ai][bj][m][n]; *(f32x4*)(xp + bj * HALF + n * 16) = x; } }
    }
};

struct EpiProj {
    static constexpr bool PERM = true, AFTER_DRAIN = false;
    bf16_t* P; int ldp; const float* cosR; const float* sinR; const float* cosC; const float* sinC; int seq; float qs;
    __device__ __forceinline__ void operator()(const f32x4 (&acc)[2][2][4][2], const Unit& u, int wr, int wc, int fr, int fq) const {
        const int row0 = u.pm * BM + wr * 64 + fr;
#pragma unroll
        for (int bj = 0; bj < 2; ++bj) {
            const int hc = u.pn * BM + bj * HALF;
            int mode = 0; float sc = 1.0f;
            if (hc < 512) { mode = 1; sc = qs; } else if (hc < 1024) { mode = 1; } else if (hc < 1536) { mode = 0; } else if (hc < 2560) { mode = 2; }
            else if (hc < 3072) { mode = 1; sc = qs; } else if (hc < 3200) { mode = 1; } else if (hc < 3328) { mode = 0; } else if (hc < 3840) { mode = 0; sc = qs; }
            const float* ct = (wc & 1) ? cosC : cosR; const float* st = (wc & 1) ? sinC : sinR;
#pragma unroll
            for (int ai = 0; ai < 2; ++ai)
#pragma unroll
                for (int m = 0; m < 4; ++m) { const int row = row0 + ai * HALF + m * 16;
                    f32x4 v0 = acc[ai][bj][m][0], v1 = acc[ai][bj][m][1];
                    if (mode == 1) { if (row < seq) { const int pos = (wc & 1) ? (row & 63) : (row >> 6);
                            const f32x4 c = *(const f32x4*)(ct + pos * 16 + 4 * fq), s = *(const f32x4*)(st + pos * 16 + 4 * fq);
                            const f32x4 o0 = v0 * c - v1 * s, o1 = v0 * s + v1 * c; v0 = o0; v1 = o1; } }
                    else if (mode == 2) { v0 = (f32x4){gelu_tanh_f(v0[0]), gelu_tanh_f(v0[1]), gelu_tanh_f(v0[2]), gelu_tanh_f(v0[3])}; v1 = (f32x4){gelu_tanh_f(v1[0]), gelu_tanh_f(v1[1]), gelu_tanh_f(v1[2]), gelu_tanh_f(v1[3])}; }
                    v0 = v0 * sc; v1 = v1 * sc;
                    u32x4 w; w.x = cvt_pk_bf16(v0[0], v0[1]); w.y = cvt_pk_bf16(v0[2], v0[3]); w.z = cvt_pk_bf16(v1[0], v1[1]); w.w = cvt_pk_bf16(v1[2], v1[3]);
                    *(u32x4*)(P + (size_t)row * ldp + hc + wc * 32 + 8 * fq) = w; }
        }
    }
};
template <class Epi, class Sched, bool ALIGN_EPI = false, bool SP2 = false>
__device__ __forceinline__ void gemm_phase(PG8_LAS unsigned char* lds, const Gemm g, const Sched& S, const Epi& E, const int tid) {
    const int wid = __builtin_amdgcn_readfirstlane(tid >> 6), lane = tid & 63, wr = wid >> 2, wc = wid & 3, fr = lane & 15, fq = lane >> 4;
    const int K = g.K, nt = K / BK;
    unsigned voffA[2], voffB[2];
#pragma unroll
    for (int i = 0; i < 2; ++i) { int R, C; stage_rc(tid * 16 + i * 8192, R, C); const int Rb = Epi::PERM ? ((R & ~31) + perm32(R & 31)) : R;
        voffA[i] = (unsigned)(R * K + C) * 2u; voffB[i] = (unsigned)(Rb * K + C) * 2u; }
    const size_t kstep = (size_t)(BK * 2);
    const size_t hstep = (size_t)HALF * K * 2;
    const size_t tstep = 2 * hstep;
    const unsigned ldsw = (unsigned)wid * 1024u;
    const int aoff = lds_byte(wr * 64 + fr, fq * 8), boff = lds_byte(wc * 32 + fr, fq * 8);
#define PG8_SA(b, h) (((b) * 2 + (h)) * HTB)
#define PG8_SB(b, h) ((4 + (b) * 2 + (h)) * HTB)
#define PG8_STAGE(bufoff, gbase, voff) do { _Pragma("unroll") for (int _i = 0; _i < 2; ++_i) \
        __builtin_amdgcn_global_load_lds((const unsigned*)((const char*)(gbase) + (voff)[_i]), (PG8_LAS unsigned*)(lds + (bufoff) + ldsw + _i * 8192), 16, 0, 0); } while (0)
#define PG8_LDA(dst, b, h) do { _Pragma("unroll") for (int m = 0; m < 4; ++m) _Pragma("unroll") for (int k = 0; k < 2; ++k) dst[m][k] = *(const PG8_LAS bf16x8*)(lds + PG8_SA(b, h) + aoff + m * 2048 + k * 1024); } while (0)
#define PG8_LDB(dst, b, h) do { _Pragma("unroll") for (int n = 0; n < 2; ++n) _Pragma("unroll") for (int k = 0; k < 2; ++k) dst[n][k] = *(const PG8_LAS bf16x8*)(lds + PG8_SB(b, h) + boff + n * 2048 + k * 1024); } while (0)
#define PG8_MMA(ai, bj, At, Bt) do { __builtin_amdgcn_s_setprio(1); _Pragma("unroll") for (int m = 0; m < 4; ++m) _Pragma("unroll") for (int n = 0; n < 2; ++n) _Pragma("unroll") for (int k = 0; k < 2; ++k) \
        acc[ai][bj][m][n] = __builtin_amdgcn_mfma_f32_16x16x32_bf16(Bt[n][k], At[m][k], acc[ai][bj][m][n], 0, 0, 0); __builtin_amdgcn_s_setprio(0); } while (0)
#define PG8_WAIT_V(n) asm volatile("s_waitcnt vmcnt(" #n ")" ::: "memory")
#define PG8_WAIT_L(n) asm volatile("s_waitcnt lgkmcnt(" #n ")" ::: "memory")
#define PG8_BAR __builtin_amdgcn_s_barrier()
#define PG8_SCHED __builtin_amdgcn_sched_barrier(0)
    Unit cur, nxt; int ui = 0;
    if (!S.next(0, cur)) return;
    f32x4 acc[2][2][4][2];
#pragma unroll
    for (int a = 0; a < 2; ++a)
#pragma unroll
        for (int b = 0; b < 2; ++b)
#pragma unroll
            for (int m = 0; m < 4; ++m)
#pragma unroll
                for (int n = 0; n < 2; ++n) acc[a][b][m][n] = (f32x4){0.f, 0.f, 0.f, 0.f};
    bf16x8 At[4][2], B0[2][2], B1[2][2];
    const char* cA = (const char*)g.A + (size_t)cur.pm * tstep; const char* cB = (const char*)g.Bt + (size_t)cur.pn * tstep;
    S.a_ready(cur);
    if constexpr (SP2) {
        PG8_STAGE(PG8_SB(0, 0), cB, voffB); PG8_STAGE(PG8_SB(0, 1), cB + hstep, voffB); PG8_STAGE(PG8_SA(0, 0), cA, voffA); PG8_STAGE(PG8_SA(0, 1), cA + hstep, voffA);
        if (wr == 1) PG8_BAR;
        PG8_WAIT_V(2); PG8_BAR;
        PG8_STAGE(PG8_SB(1, 0), cB + kstep, voffB); PG8_STAGE(PG8_SA(1, 0), cA + kstep, voffA); PG8_STAGE(PG8_SB(1, 1), cB + hstep + kstep, voffB);
        PG8_WAIT_V(6); PG8_BAR;
    } else {
        PG8_STAGE(PG8_SB(0, 0), cB, voffB); PG8_STAGE(PG8_SA(0, 0), cA, voffA); PG8_STAGE(PG8_SB(0, 1), cB + hstep, voffB); PG8_STAGE(PG8_SA(0, 1), cA + hstep, voffA);
        if (wr == 1) PG8_BAR;
        PG8_WAIT_V(4); PG8_BAR;
        PG8_STAGE(PG8_SB(1, 0), cB + kstep, voffB); PG8_STAGE(PG8_SA(1, 0), cA + kstep, voffA); PG8_STAGE(PG8_SB(1, 1), cB + hstep + kstep, voffB);
        PG8_WAIT_V(6); PG8_BAR;
    }
    for (;;) {
        const bool has_next = S.next(ui + 1, nxt);
        const char* nA = has_next ? (const char*)g.A + (size_t)nxt.pm * tstep : cA; const char* nB = has_next ? (const char*)g.Bt + (size_t)nxt.pn * tstep : cB;
        for (int t = 0; t < nt; t += 2) {
            const bool last = (t == nt - 2);
            const char* a1 = cA + (size_t)(t + 1) * kstep;
            const char* a2 = last ? nA : cA + (size_t)(t + 2) * kstep; const char* b2 = last ? nB : cB + (size_t)(t + 2) * kstep;
            const char* a3 = a2 + kstep; const char* b3 = b2 + kstep;
            if (last && has_next) S.a_ready(nxt);
            if constexpr (SP2) {
            PG8_LDB(B0, 0, 0); PG8_LDB(B1, 0, 1); PG8_SCHED; PG8_LDA(At, 0, 0); PG8_STAGE(PG8_SA(1, 1), a1 + hstep, voffA);
            PG8_WAIT_V(8); PG8_WAIT_L(0); PG8_BAR; PG8_MMA(0, 0, At, B0); PG8_MMA(0, 1, At, B1); PG8_BAR; PG8_SCHED;
            PG8_LDA(At, 0, 1); PG8_STAGE(PG8_SB(0, 0), b2, voffB); PG8_STAGE(PG8_SB(0, 1), b2 + hstep, voffB); PG8_STAGE(PG8_SA(0, 0), a2, voffA);
            PG8_WAIT_V(8); PG8_WAIT_L(0); PG8_BAR; PG8_MMA(1, 0, At, B0); PG8_MMA(1, 1, At, B1); PG8_BAR; PG8_SCHED;
            PG8_LDB(B0, 1, 0); PG8_LDB(B1, 1, 1); PG8_SCHED; PG8_LDA(At, 1, 0); PG8_STAGE(PG8_SA(0, 1), a2 + hstep, voffA);
            PG8_WAIT_V(8); PG8_WAIT_L(0); PG8_BAR; PG8_MMA(0, 0, At, B0); PG8_MMA(0, 1, At, B1); PG8_BAR; PG8_SCHED;
            PG8_LDA(At, 1, 1); PG8_STAGE(PG8_SB(1, 0), b3, voffB); PG8_STAGE(PG8_SB(1, 1), b3 + hstep, voffB); PG8_STAGE(PG8_SA(1, 0), a3, voffA);
            PG8_WAIT_V(8); PG8_WAIT_L(0); PG8_BAR; PG8_MMA(1, 0, At, B0); PG8_MMA(1, 1, At, B1); PG8_BAR; PG8_SCHED;
            } else {
            PG8_LDB(B0, 0, 0); PG8_SCHED; PG8_LDA(At, 0, 0); PG8_STAGE(PG8_SA(1, 1), a1 + hstep, voffA);
            PG8_WAIT_L(8); PG8_BAR; PG8_WAIT_L(0); PG8_MMA(0, 0, At, B0); PG8_BAR; PG8_SCHED;
            PG8_LDB(B1, 0, 1); PG8_STAGE(PG8_SB(0, 0), b2, voffB);
            PG8_BAR; PG8_WAIT_L(0); PG8_MMA(0, 1, At, B1); PG8_BAR;
            PG8_LDA(At, 0, 1); PG8_STAGE(PG8_SA(0, 0), a2, voffA);
            PG8_BAR; PG8_WAIT_L(0); PG8_MMA(1, 0, At, B0); PG8_BAR; PG8_SCHED;
            PG8_STAGE(PG8_SB(0, 1), b2 + hstep, voffB);
            PG8_WAIT_V(6); PG8_BAR; PG8_MMA(1, 1, At, B1); PG8_BAR;
            PG8_LDB(B0, 1, 0); PG8_SCHED; PG8_LDA(At, 1, 0); PG8_STAGE(PG8_SA(0, 1), a2 + hstep, voffA);
            PG8_WAIT_L(8); PG8_BAR; PG8_WAIT_L(0); PG8_MMA(0, 0, At, B0); PG8_BAR; PG8_SCHED;
            PG8_LDB(B1, 1, 1); PG8_STAGE(PG8_SB(1, 0), b3, voffB);
            PG8_BAR; PG8_WAIT_L(0); PG8_MMA(0, 1, At, B1); PG8_BAR;
            PG8_LDA(At, 1, 1); PG8_STAGE(PG8_SA(1, 0), a3, voffA);
            PG8_BAR; PG8_WAIT_L(0); PG8_MMA(1, 0, At, B0); PG8_BAR; PG8_SCHED;
            PG8_STAGE(PG8_SB(1, 1), b3 + hstep, voffB);
            PG8_WAIT_V(6); PG8_BAR; PG8_MMA(1, 1, At, B1); PG8_BAR;
            }
        }
        if constexpr (ALIGN_EPI) { if (wr == 0) PG8_BAR; }
        if constexpr (!Epi::AFTER_DRAIN) { E(acc, cur, wr, wc, fr, fq); S.done(cur); }
        if (!has_next) break;
#pragma unroll
        for (int a = 0; a < 2; ++a)
#pragma unroll
            for (int b = 0; b < 2; ++b)
#pragma unroll
                for (int m = 0; m < 4; ++m)
#pragma unroll
                    for (int n = 0; n < 2; ++n) acc[a][b][m][n] = (f32x4){0.f, 0.f, 0.f, 0.f};
        cur = nxt; cA = nA; cB = nB; ++ui;
        if constexpr (ALIGN_EPI) { if (wr == 1) PG8_BAR; }
    }
    PG8_WAIT_V(0);
    if constexpr (!ALIGN_EPI) { if (wr == 0) PG8_BAR; }
    PG8_BAR;
    if constexpr (Epi::AFTER_DRAIN) { E.fused(acc, cur, wr, wc, fr, fq, lds, wid, lane); S.done(cur); }
#undef PG8_SA
#undef PG8_SB
#undef PG8_STAGE
#undef PG8_LDA
#undef PG8_LDB
#undef PG8_MMA
#undef PG8_WAIT_V
#undef PG8_WAIT_L
#undef PG8_BAR
#undef PG8_SCHED
}
}
#define GAS __attribute__((address_space(1)))
#define LAS __attribute__((address_space(3)))
typedef unsigned short bf16;
typedef unsigned v4u __attribute__((ext_vector_type(4)));
typedef float f32x4 __attribute__((ext_vector_type(4)));
typedef short bf16x8 __attribute__((ext_vector_type(8)));
typedef GAS unsigned gu32;
typedef GAS unsigned long long gu64;
#define RLX_AGENT __ATOMIC_RELAXED, __HIP_MEMORY_SCOPE_AGENT
#define LDS_WAIT() asm volatile("s_waitcnt lgkmcnt(0)" ::: "memory")
#define VM_WAIT() asm volatile("s_waitcnt vmcnt(0)" ::: "memory")
__device__ __forceinline__ unsigned long long rt() { return __builtin_amdgcn_s_memrealtime(); }
__device__ __forceinline__ unsigned f2bf(float f) { unsigned u = __builtin_bit_cast(unsigned, f); return (u + 0x7fffu + ((u >> 16) & 1u)) >> 16; }
__device__ __forceinline__ unsigned pk2(float lo, float hi) { return f2bf(lo) | (f2bf(hi) << 16); }

#define XB_TMO      128
#define XB_XCNT(j)  (256  + 64 * (j))
#define XB_XSUB(j)  (1280 + 64 * (j))
#define XB_XGEN(j)  (2304 + 64 * (j))
#define XB_TOP      3328
#define XB_TOPGEN   3392
#define XCD_BAR_WORDS 3456
#define XB_SPIN_CAP (1u << 18)

__device__ __forceinline__ unsigned xb_ld(unsigned* p)              { return __hip_atomic_load(p, __ATOMIC_RELAXED, __HIP_MEMORY_SCOPE_AGENT); }
__device__ __forceinline__ unsigned xb_add(unsigned* p, unsigned v) { return __hip_atomic_fetch_add(p, v, __ATOMIC_RELAXED, __HIP_MEMORY_SCOPE_AGENT); }
__device__ __forceinline__ unsigned xb_xcc_id() { return (unsigned)__builtin_amdgcn_s_getreg((3 << 11) | 20) & 0xFu; }
#define XB_SPIN(cond, bar) do { unsigned _sp = 0; while (cond) { __builtin_amdgcn_s_sleep(1); \
    if ((++_sp & 255u) == 0u) { if (xb_ld(&(bar)[XB_TMO])) break; if (_sp > XB_SPIN_CAP) { atomicAdd(&(bar)[XB_TMO], 1u); break; } } } } while (0)

struct XcdBarrier {
    unsigned* bar; unsigned x;
    volatile LAS unsigned* st;
};

__device__ __forceinline__ XcdBarrier xcd_barrier_post(unsigned* bar, volatile LAS unsigned* st) {
    XcdBarrier b; b.bar = bar; b.x = xb_xcc_id(); b.st = st;
    if (threadIdx.x == 0) (void)xb_add(&bar[XB_XCNT(b.x)], 1u);
    return b;
}
__device__ __forceinline__ void xcd_barrier_complete(unsigned* bar, unsigned x, unsigned& nloc, unsigned& nx) {
    const unsigned G = gridDim.x * gridDim.y * gridDim.z;
    unsigned sum, cnt, mine, sp = 0u;
    for (;;) {
        sum = 0u; cnt = 0u; mine = 0u;
#pragma unroll
        for (unsigned j = 0; j < 16; ++j) { const unsigned c = xb_ld(&bar[XB_XCNT(j)]); sum += c; cnt += (c > 0u) ? 1u : 0u; mine = (j == x) ? c : mine; }
        if (sum == G) break;
        __builtin_amdgcn_s_sleep(1);
        if ((++sp & 255u) == 0u) { if (xb_ld(&bar[XB_TMO])) break; if (sp > XB_SPIN_CAP) { atomicAdd(&bar[XB_TMO], 1u); break; } }
    }
    nloc = mine > 0u ? mine : 1u; nx = cnt > 0u ? cnt : 1u;
}

__device__ __forceinline__ void xcd_barrier(const XcdBarrier& b) {
    asm volatile("s_waitcnt vmcnt(0)" ::: "memory");
    __syncthreads();
    if (threadIdx.x == 0) {
        unsigned* bar = b.bar;
        __builtin_amdgcn_s_waitcnt(0);
        unsigned nloc = b.st[0], nx = b.st[1];
        if (nloc == 0u) { xcd_barrier_complete(bar, b.x, nloc, nx); b.st[0] = nloc; b.st[1] = nx; }
        const unsigned old = xb_add(&bar[XB_XSUB(b.x)], 1u);
        const unsigned gen = old / nloc;
        if (old + 1u == (gen + 1u) * nloc) {
            __builtin_amdgcn_fence(__ATOMIC_RELEASE, "agent");
            asm volatile("s_waitcnt vmcnt(0)" ::: "memory");
            const unsigned og = xb_add(&bar[XB_TOP], 1u);
            const unsigned tg = og / nx;
            if (og + 1u == (tg + 1u) * nx) xb_add(&bar[XB_TOPGEN], 1u);
            else XB_SPIN(xb_ld(&bar[XB_TOPGEN]) == tg, bar);
            __builtin_amdgcn_fence(__ATOMIC_ACQUIRE, "agent");
            xb_add(&bar[XB_XGEN(b.x)], 1u);
            asm volatile("s_waitcnt vmcnt(0)" ::: "memory");
        } else {
            XB_SPIN(xb_ld(&bar[XB_XGEN(b.x)]) == gen, bar);
            __builtin_amdgcn_fence(__ATOMIC_ACQUIRE, "agent");
            asm volatile("s_waitcnt vmcnt(0)" ::: "memory");
        }
    }
    __syncthreads();
}

constexpr int DM = 2048, SEQ = 16384, CTXL = 256, MTOT = SEQ + CTXL, NLAYER = 4, DFF = 5632, DPROJ = 4864, NMOD = 9, MODW = NMOD * DM;
constexpr int NWAVES = 8, NTHREADS = NWAVES * 64;
constexpr float LN_EPS = 1e-6f, ALPHA = 1.681792830507429f, LOG2E = 1.4426950408889634f, QS = 0.125f * LOG2E;
constexpr int C_AQ = 0, C_AK = 512, C_AV = 1024, C_BU = 1536, C_BV = 2048, C_CQ = 2560, C_CK = 3072, C_CV = 3200, C_DQ = 3328, C_DK = 3840, C_DV = 4352;

constexpr size_t MiB = 1u << 20;
constexpr size_t WS_CTL = 0, CTL_ZERO_BYTES = 1 * MiB;
constexpr size_t WS_MOD = 1 * MiB;
constexpr size_t WS_LAM = WS_MOD + 640 * 1024;
constexpr size_t WS_ROPE = WS_MOD + 704 * 1024;
constexpr size_t WS_WSP = 3 * MiB;
constexpr size_t WS_W = 4 * MiB;
constexpr size_t W_1IN = 0, W_1OUT = 44 * MiB, W_2IN = 66 * MiB, W_2OUT = 110 * MiB, W_MI = 132 * MiB, W_MO = 151 * MiB, W_LAYER = 159 * MiB;
constexpr size_t WS_X = 640 * MiB;
constexpr size_t WS_XM = 770 * MiB;
constexpr size_t WS_H = 835 * MiB;
constexpr size_t WS_PROJ = 1014 * MiB;
constexpr size_t WS_YCAT = 1169 * MiB;
constexpr size_t WS_END = 1234 * MiB;
static_assert(WS_W + NLAYER * W_LAYER <= WS_X && WS_X + (size_t)MTOT * DM * 4 <= WS_XM && WS_XM + (size_t)MTOT * DM * 2 <= WS_H && WS_H + (size_t)MTOT * DFF * 2 <= WS_PROJ &&
              WS_PROJ + (size_t)MTOT * DPROJ * 2 <= WS_YCAT && WS_YCAT + (size_t)MTOT * DM * 2 <= WS_END, "d_ws map");
constexpr int CW_TMO = 0, CW_BAR = 4096;
constexpr int RING_OFF = 0, RING_BYTES = 131072;
constexpr int LDSCTL_OFF = RING_BYTES, MISC_OFF = LDSCTL_OFF + 320;
constexpr int LDS_BYTES = 147456;

struct Args { const float* in[21]; float* out; unsigned char* ws; int ph_lo, ph_hi; };
struct Frame {
    LAS unsigned char* lds;
    unsigned char* ws;
    int tid, lane, wave, G, gw, ngw, bid;
};
__device__ __forceinline__ float wave_sum(float v) {
#pragma unroll
    for (int o = 1; o < 64; o <<= 1) v += __shfl_xor(v, o);
    return v;
}
__device__ __forceinline__ unsigned cvt2(float lo, float hi) { typedef float f2 __attribute__((ext_vector_type(2))); typedef __bf16 b2 __attribute__((ext_vector_type(2))); f2 v = {lo, hi}; b2 b = __builtin_convertvector(v, b2); return __builtin_bit_cast(unsigned, b); }
__device__ __forceinline__ float bf_lo(unsigned w) { return __uint_as_float(w << 16); }
__device__ __forceinline__ float bf_hi(unsigned w) { return __uint_as_float(w & 0xffff0000u); }

__device__ const float ROPE_INV[16] = {1.000000000e+00f, 5.623413324e-01f, 3.162277639e-01f, 1.778279394e-01f, 1.000000015e-01f, 5.623413250e-02f, 3.162277490e-02f, 1.778279431e-02f,
                                       9.999999776e-03f, 5.623413250e-03f, 3.162277630e-03f, 1.778279431e-03f, 1.000000047e-03f, 5.623413017e-04f, 3.162277571e-04f, 1.778279402e-04f};

__device__ __forceinline__ int map_dest(int mapk, int n) {
    if (mapk == 1) { const int s = n >= DFF ? 1 : 0, hid = n - s * DFF; return (hid >> 7) * 256 + s * 128 + (hid & 127); }
    if (mapk == 2) { const bool rope = (n < C_AV) || (n >= C_CQ && n < C_CV); if (rope) { const int d = n & 63; return (n & ~63) + 32 * ((d >> 4) & 1) + 8 * ((d >> 2) & 3) + 4 * (d >> 5) + (d & 3); } }
    return n;
}
__device__ __forceinline__ void transpose_item(const float* W, int K, int N, bf16* WT, int mapk, LAS float* scr, int item, int lane) {
    const int nblk = N / 32, kb = item / nblk, nb = item % nblk, k0 = 64 * kb, n0 = 32 * nb;
#pragma unroll 8
    for (int i = 0; i < 32; ++i) { const int kk = 2 * i + (lane >> 5); scr[kk * 33 + (lane & 31)] = W[(size_t)(k0 + kk) * N + n0 + (lane & 31)]; }
    LDS_WAIT(); asm volatile("" ::: "memory");
    const int c = lane & 7;
#pragma unroll
    for (int j = 0; j < 4; ++j) { const int n = (lane >> 3) + 8 * j; const LAS float* s = scr + (8 * c) * 33 + n;
        v4u o; o.x = pk2(s[0 * 33], s[1 * 33]); o.y = pk2(s[2 * 33], s[3 * 33]); o.z = pk2(s[4 * 33], s[5 * 33]); o.w = pk2(s[6 * 33], s[7 * 33]);
        *(GAS v4u*)(WT + (size_t)map_dest(mapk, n0 + n) * K + k0 + 8 * c) = o; }
    LDS_WAIT(); asm volatile("" ::: "memory");
}
__device__ __forceinline__ void sincos_acc(float ang, float& s, float& c) {
    const double x = (double)ang, k = __builtin_rint(x * 0.15915494309189535);
    const double y = (x - k * 6.283185307179586) - k * 2.4492935982947064e-16, y2 = y * y;
    double ts = y, ss = y, tc = 1.0, cs = 1.0;
    for (int n = 1; n <= 14; ++n) { tc *= -y2 / (double)((2 * n - 1) * (2 * n)); cs += tc; ts *= -y2 / (double)((2 * n) * (2 * n + 1)); ss += ts; }
    s = (float)ss; c = (float)cs;
}
__device__ __forceinline__ float silu_s(float x) { return x / (1.0f + __expf(-x)); }

__device__ __forceinline__ void p0a(Frame& F, const Args& A) {
    LAS float* sc = (LAS float*)(F.lds + RING_OFF); LAS float* scc = sc + DM; LAS float* red = sc + 2 * DM;
    for (int i = F.tid; i < DM; i += NTHREADS) { sc[i] = silu_s(A.in[1][i]); scc[i] = silu_s(A.in[3][i]); }
    __syncthreads();
    { const int cq = F.tid & 15, ks = F.tid >> 4;
      for (int it = F.bid; it < NLAYER * (MODW / 64); it += F.G) {
        const int l = it / (MODW / 64), jg = it % (MODW / 64);
        const float* Wl = A.in[4] + (size_t)l * DM * MODW + 64 * jg + 4 * cq + (size_t)(ks * 64) * MODW;
        f32x4 ax = {0.f, 0.f, 0.f, 0.f}, ac = {0.f, 0.f, 0.f, 0.f};
#pragma unroll 8
        for (int kk = 0; kk < 64; ++kk) { const f32x4 w = *(const GAS f32x4*)(Wl + (size_t)kk * MODW); ax += w * sc[ks * 64 + kk]; ac += w * scc[ks * 64 + kk]; }
        LAS float* rp = red + (ks * 16 + cq) * 8;
        rp[0] = ax[0]; rp[1] = ax[1]; rp[2] = ax[2]; rp[3] = ax[3]; rp[4] = ac[0]; rp[5] = ac[1]; rp[6] = ac[2]; rp[7] = ac[3];
        __syncthreads();
        if (F.tid < 128) { const int cq2 = F.tid & 15, comp = F.tid >> 4; float s = 0.f;
            for (int k2 = 0; k2 < 32; ++k2) s += red[(k2 * 16 + cq2) * 8 + comp];
            const int j = 64 * jg + 4 * cq2 + (comp & 3), ty = comp >> 2;
            ((float*)(F.ws + WS_MOD))[(size_t)(l * 2 + ty) * MODW + j] = s + A.in[5][(size_t)l * MODW + j]; }
        __syncthreads();
      } }
    { LAS float* scr = (LAS float*)(F.lds + RING_OFF + F.wave * 16384);
      constexpr int I_IN = (DM / 64) * (2 * DFF / 32), I_OUT = (DFF / 64) * (DM / 32), I_MI = (DM / 64) * (DPROJ / 32), I_MO = (DM / 64) * (DM / 32), I_L = 2 * I_IN + 2 * I_OUT + I_MI + I_MO;
      for (int it = F.gw; it < NLAYER * I_L; it += F.ngw) {
        const int l = it / I_L; int r = it % I_L; bf16* Wl = ((bf16*)(F.ws + WS_W)) + (size_t)l * (W_LAYER / 2);
        if (r < I_IN) { transpose_item(A.in[8] + (size_t)l * DM * 2 * DFF, DM, 2 * DFF, Wl + W_1IN / 2, 1, scr, r, F.lane); continue; } r -= I_IN;
        if (r < I_OUT) { transpose_item(A.in[9] + (size_t)l * DFF * DM, DFF, DM, Wl + W_1OUT / 2, 0, scr, r, F.lane); continue; } r -= I_OUT;
        if (r < I_IN) { transpose_item(A.in[10] + (size_t)l * DM * 2 * DFF, DM, 2 * DFF, Wl + W_2IN / 2, 1, scr, r, F.lane); continue; } r -= I_IN;
        if (r < I_OUT) { transpose_item(A.in[11] + (size_t)l * DFF * DM, DFF, DM, Wl + W_2OUT / 2, 0, scr, r, F.lane); continue; } r -= I_OUT;
        if (r < I_MI) { transpose_item(A.in[12] + (size_t)l * DM * DPROJ, DM, DPROJ, Wl + W_MI / 2, 2, scr, r, F.lane); continue; } r -= I_MI;
        transpose_item(A.in[13] + (size_t)l * DM * DM, DM, DM, Wl + W_MO / 2, 0, scr, r, F.lane);
      } }
    { const int gt = F.bid * NTHREADS + F.tid, ngt = F.G * NTHREADS;
      for (int e = gt; e < 320 * 16; e += ngt) { const int pos = e >> 4, f = e & 15; float s, c;
        if (pos < 256) { sincos_acc((float)pos * ROPE_INV[f], s, c); ((float*)(F.ws + WS_ROPE))[pos * 16 + f] = c; ((float*)(F.ws + WS_ROPE))[4096 + pos * 16 + f] = s; }
        else { const int p2 = pos - 256; sincos_acc((float)p2 * ROPE_INV[f], s, c); ((float*)(F.ws + WS_ROPE))[8192 + p2 * 16 + f] = c; ((float*)(F.ws + WS_ROPE))[9216 + p2 * 16 + f] = s; } }
      for (int e = gt; e < NLAYER * 4 * 128 * 128; e += ngt) ((bf16*)(F.ws + WS_WSP))[e] = (bf16)f2bf(A.in[17][e]);
      if (gt < NLAYER) { const float* lv = A.in[14] + gt * 256; float s01 = 0.f, s23 = 0.f;
        for (int i = 0; i < 64; ++i) { s01 += lv[i] * lv[64 + i]; s23 += lv[128 + i] * lv[192 + i]; }
        const float li = 0.8f - 0.6f * expf(-0.3f * (float)gt);
        ((float*)(F.ws + WS_LAM))[gt * 4 + 0] = expf(s01) - expf(s23) + li; ((float*)(F.ws + WS_LAM))[gt * 4 + 1] = 1.0f - li; } }
}
__device__ __forceinline__ void p0b(Frame& F, const Args& A) {
    for (int row = F.gw; row < MTOT; row += F.ngw) {
        const float* src = row < SEQ ? A.in[0] + (size_t)row * DM : A.in[2] + (size_t)(row - SEQ) * DM;
        const float* mod = ((float*)(F.ws + WS_MOD)) + (size_t)(row >= SEQ ? 1 : 0) * MODW;
#pragma unroll
        for (int j = 0; j < 8; ++j) { const int idx = (F.lane + 64 * j) * 4;
            const f32x4 v = *(const GAS f32x4*)(src + idx), sh = *(const GAS f32x4*)(mod + idx), sc = *(const GAS f32x4*)(mod + DM + idx);
            *(GAS f32x4*)(((float*)(F.ws + WS_X)) + (size_t)row * DM + idx) = v;
            const f32x4 o = v * (sc + 1.0f) + sh;
            *(GAS unsigned long long*)(((bf16*)(F.ws + WS_XM)) + (size_t)row * DM + idx) = (unsigned long long)cvt2(o[0], o[1]) | ((unsigned long long)cvt2(o[2], o[3]) << 32); }
    }
}
__device__ __forceinline__ void ln_pass(Frame& F, const Args& A, const float* g, const float* b, const float* mod_lat, const float* mod_ctx, int ish, int isc, int nrows, float* fin) {
    for (int row = F.gw; row < nrows; row += F.ngw) {
        float* xr = ((float*)(F.ws + WS_X)) + (size_t)row * DM; f32x4 v[8]; float s = 0.f;
#pragma unroll
        for (int j = 0; j < 8; ++j) { v[j] = *(const GAS f32x4*)(xr + (F.lane + 64 * j) * 4); s += (v[j][0] + v[j][1]) + (v[j][2] + v[j][3]); }
        const float mean = wave_sum(s) * (1.0f / DM); float s2 = 0.f;
#pragma unroll
        for (int j = 0; j < 8; ++j) { v[j] = v[j] - mean; s2 += (v[j][0] * v[j][0] + v[j][1] * v[j][1]) + (v[j][2] * v[j][2] + v[j][3] * v[j][3]); }
        const float rstd = 1.0f / sqrtf(wave_sum(s2) * (1.0f / DM) + LN_EPS);
        const float* mod = row >= SEQ ? mod_ctx : mod_lat;
#pragma unroll
        for (int j = 0; j < 8; ++j) { const int idx = (F.lane + 64 * j) * 4;
            const f32x4 gg = *(const GAS f32x4*)(g + idx), bb = *(const GAS f32x4*)(b + idx);
            const f32x4 xn = v[j] * rstd * gg + bb;
            if (fin) { *(GAS f32x4*)(fin + (size_t)row * DM + idx) = xn; }
            else { *(GAS f32x4*)(xr + idx) = xn;
                const f32x4 sh = *(const GAS f32x4*)(mod + ish * DM + idx), sc = *(const GAS f32x4*)(mod + isc * DM + idx);
                const f32x4 o = xn * (sc + 1.0f) + sh;
                *(GAS unsigned long long*)(((bf16*)(F.ws + WS_XM)) + (size_t)row * DM + idx) = (unsigned long long)cvt2(o[0], o[1]) | ((unsigned long long)cvt2(o[2], o[3]) << 32); } }
    }
}

typedef float f32x16 __attribute__((ext_vector_type(16)));
typedef short s16x4 __attribute__((ext_vector_type(4)));
typedef short v4i16_t __attribute__((ext_vector_type(4)));
__device__ __forceinline__ int crow(int i, int h) { return (i & 3) + 8 * (i >> 2) + 4 * h; }
__device__ __forceinline__ s16x4 vtr(LAS const unsigned char* p) { return __builtin_bit_cast(s16x4, __builtin_amdgcn_ds_read_tr16_b64_v4i16((LAS v4i16_t*)p)); }
#define MFMA32(a, b, c) __builtin_amdgcn_mfma_f32_32x32x16_bf16((a), (b), (c), 0, 0, 0)
constexpr int L_K = 0, L_V = 17408, L_CMB = 40960, L_BIAS = 106496;

template <int MODE>
__device__ __forceinline__ void attn_unit(Frame& F, const Args& A, int uidx, bool is_ctx, int layer) {
    constexpr int KD = (MODE == 0) ? 128 : 64, NCH = KD / 64, KP = KD * 2 + 16, VP = KD * 2 + 64, NEB = KD / 32;
    const int tid = F.tid, lane = F.lane, w = F.wave, r = lane & 31, h = lane >> 5;
    LAS unsigned char* lds = F.lds + RING_OFF;
    const bf16* PROJ = ((bf16*)(F.ws + WS_PROJ));
    int qrow, qcol, kcol0, vcol0, kcl = 0, nctx, nb0, nt, ocol;
    int gr = 0, my_rs = 0, sub = 0;
    float sink2 = 0.f;
    if (MODE == 0) {
        const int head = uidx & 3, qb = uidx >> 2; sub = w >> 1; const int comp = w & 1;
        qrow = (is_ctx ? SEQ : 0) + 128 * qb + 32 * sub; qcol = C_AQ + 128 * head + 64 * comp; kcol0 = C_AK + 128 * head; vcol0 = C_AV + 128 * head; kcl = 64 * comp;
        if (is_ctx) { nctx = 4; nb0 = 0; nt = 4; } else { nctx = 0; nb0 = 0; nt = MTOT / 64; }
        ocol = 128 * head;
    } else if (MODE == 1) {
        const int kv = uidx & 1, qb = uidx >> 1; const int g = w >> 1; sub = w & 1; const int head = 4 * kv + g;
        qrow = (is_ctx ? SEQ : 0) + 64 * qb + 32 * sub; qcol = C_CQ + 64 * head; kcol0 = C_CK + 64 * kv; vcol0 = C_CV + 64 * kv;
        nctx = 4;
        if (is_ctx) { nb0 = 0; nt = 4; } else { const int b0 = qb - 2 < 0 ? 0 : qb - 2, b1 = qb + 2 > 255 ? 255 : qb + 2; nb0 = b0; nt = 4 + (b1 - b0 + 1); }
        ocol = 1024 + 64 * head;
        sink2 = A.in[19][layer * 8 + head] * LOG2E;
    } else {
        const int head = uidx & 7, rg = uidx >> 3;
        qcol = C_DQ + 64 * head; kcol0 = C_DK + 64 * head; vcol0 = C_DV + 64 * head; nctx = 4; ocol = 1536 + 64 * head;
        if (is_ctx) { qrow = SEQ + 32 * w; nb0 = 0; nt = 4; }
        else { gr = 4 * rg + (w >> 1); qrow = 64 * gr + 32 * (w & 1);
            int lo = 4 * rg - 4; lo = lo < 0 ? 0 : (lo > 248 ? 248 : lo); int hi = 4 * rg + 3 - 4; hi = hi < 0 ? 0 : (hi > 248 ? 248 : hi); hi += 7;
            nb0 = lo; nt = 4 + (hi - lo + 1); my_rs = gr - 4; my_rs = my_rs < 0 ? 0 : (my_rs > 248 ? 248 : my_rs);
            LAS float* bl = (LAS float*)(lds + L_BIAS);
            for (int i = tid; i < 15 * 31; i += NTHREADS) bl[i] = A.in[20][(size_t)(layer * 8 + head) * 465 + i] * LOG2E; }
    }
    bf16x8 qf[4];
#pragma unroll
    for (int s = 0; s < 4; ++s) qf[s] = *(const GAS bf16x8*)(PROJ + (size_t)(qrow + r) * DPROJ + qcol + 16 * s + 8 * h);
    f32x16 o[NEB];
#pragma unroll
    for (int e = 0; e < NEB; ++e)
#pragma unroll
        for (int i = 0; i < 16; ++i) o[e][i] = 0.f;
    float m_run = -1e30f, l_run = 0.f;
    v4u kreg[NCH], vreg[NCH];
#define TILE_ROW(t) (((t) < nctx) ? (SEQ + 64 * (t)) : 64 * (nb0 + (t) - nctx))
#define TILE_GLOAD(t) do { const int rb_ = TILE_ROW(t); _Pragma("unroll") for (int i_ = 0; i_ < NCH; ++i_) { const int c_ = tid + NTHREADS * i_, row_ = c_ / (KD / 8), cc_ = c_ % (KD / 8); \
        kreg[i_] = *(const GAS v4u*)(PROJ + (size_t)(rb_ + row_) * DPROJ + kcol0 + 8 * cc_); vreg[i_] = *(const GAS v4u*)(PROJ + (size_t)(rb_ + row_) * DPROJ + vcol0 + 8 * cc_); } } while (0)
#define TILE_LSTORE() do { _Pragma("unroll") for (int i_ = 0; i_ < NCH; ++i_) { const int c_ = tid + NTHREADS * i_, row_ = c_ / (KD / 8), cc_ = c_ % (KD / 8); \
        *(LAS v4u*)(lds + L_K + row_ * KP + cc_ * 16) = kreg[i_]; *(LAS v4u*)(lds + L_V + row_ * VP + cc_ * 16) = vreg[i_]; } } while (0)
    TILE_GLOAD(0);
    const int li = lane & 15, lblk = (lane >> 4) & 1;
    for (int t = 0; t < nt; ++t) {
        __syncthreads();
        TILE_LSTORE();
        __syncthreads();
        if (t + 1 < nt) TILE_GLOAD(t + 1);
        bool active = true;
        int kr = 0;
        if (MODE == 2 && t >= nctx) { kr = nb0 + t - nctx; active = (kr >= my_rs) && (kr <= my_rs + 7); }
        if (active) {
            f32x16 s0, s1;
#pragma unroll
            for (int i = 0; i < 16; ++i) { s0[i] = 0.f; s1[i] = 0.f; }
#pragma unroll
            for (int s = 0; s < 4; ++s) {
                const bf16x8 k0 = *(const LAS bf16x8*)(lds + L_K + r * KP + (kcl + 16 * s + 8 * h) * 2);
                const bf16x8 k1 = *(const LAS bf16x8*)(lds + L_K + (32 + r) * KP + (kcl + 16 * s + 8 * h) * 2);
                s0 = MFMA32(k0, qf[s], s0); s1 = MFMA32(k1, qf[s], s1);
            }
            if (MODE == 1 && t >= nctx) {
                const int rb = TILE_ROW(t), qt = qrow + r;
#pragma unroll
                for (int i = 0; i < 16; ++i) { const int k0t = rb + crow(i, h), d0 = k0t - qt, d1 = d0 + 32;
                    if (d0 > 128 || d0 < -128) s0[i] = -INFINITY; if (d1 > 128 || d1 < -128) s1[i] = -INFINITY; }
            }
            if (MODE == 2 && t >= nctx) {
                const int qc = (qrow & 63) + r; int cs = qc - 8; cs = cs < 0 ? 0 : (cs > 48 ? 48 : cs);
                const LAS float* bl = (const LAS float*)(lds + L_BIAS) + (kr - gr + 7) * 31 + 15 - qc;
#pragma unroll
                for (int i = 0; i < 16; ++i) { const int kc0 = crow(i, h), kc1 = kc0 + 32;
                    s0[i] = (kc0 >= cs && kc0 < cs + 16) ? s0[i] + bl[kc0] : -INFINITY;
                    s1[i] = (kc1 >= cs && kc1 < cs + 16) ? s1[i] + bl[kc1] : -INFINITY; }
            }
            float mx = s0[0];
#pragma unroll
            for (int i = 1; i < 16; ++i) mx = fmaxf(mx, s0[i]);
#pragma unroll
            for (int i = 0; i < 16; ++i) mx = fmaxf(mx, s1[i]);
            mx = fmaxf(mx, __shfl_xor(mx, 32));
            const float m_new = fmaxf(m_run, mx), alpha = __builtin_amdgcn_exp2f(m_run - m_new);
            m_run = m_new;
            float ls = 0.f;
#pragma unroll
            for (int i = 0; i < 16; ++i) { s0[i] = __builtin_amdgcn_exp2f(s0[i] - m_new); s1[i] = __builtin_amdgcn_exp2f(s1[i] - m_new); ls += s0[i] + s1[i]; }
            l_run = l_run * alpha + ls;
#pragma unroll
            for (int e = 0; e < NEB; ++e)
#pragma unroll
                for (int i = 0; i < 16; ++i) o[e][i] *= alpha;
            bf16x8 pf[2][2];
#pragma unroll
            for (int s = 0; s < 2; ++s) {
                v4u a, b;
                a.x = cvt2(s0[8 * s + 0], s0[8 * s + 1]); a.y = cvt2(s0[8 * s + 2], s0[8 * s + 3]); a.z = cvt2(s0[8 * s + 4], s0[8 * s + 5]); a.w = cvt2(s0[8 * s + 6], s0[8 * s + 7]);
                b.x = cvt2(s1[8 * s + 0], s1[8 * s + 1]); b.y = cvt2(s1[8 * s + 2], s1[8 * s + 3]); b.z = cvt2(s1[8 * s + 4], s1[8 * s + 5]); b.w = cvt2(s1[8 * s + 6], s1[8 * s + 7]);
                pf[0][s] = __builtin_bit_cast(bf16x8, a); pf[1][s] = __builtin_bit_cast(bf16x8, b);
            }
#pragma unroll
            for (int kb = 0; kb < 2; ++kb)
#pragma unroll
                for (int s = 0; s < 2; ++s)
#pragma unroll
                    for (int e = 0; e < NEB; ++e) {
                        LAS const unsigned char* vp = lds + L_V + (32 * kb + 16 * s + 4 * h + (li >> 2)) * VP + (32 * e + 16 * lblk) * 2 + 8 * (li & 3);
                        const s16x4 lo = vtr(vp), hi = vtr(vp + 8 * VP);
                        const bf16x8 vf = {lo[0], lo[1], lo[2], lo[3], hi[0], hi[1], hi[2], hi[3]};
                        o[e] = MFMA32(vf, pf[kb][s], o[e]);
                    }
        }
    }
#undef TILE_ROW
#undef TILE_GLOAD
#undef TILE_LSTORE
    float l_tot = l_run + __shfl_xor(l_run, 32);
    if (MODE == 1) l_tot += __builtin_amdgcn_exp2f(sink2 - m_run);
    const float inv = 1.0f / l_tot;
#pragma unroll
    for (int e = 0; e < NEB; ++e)
#pragma unroll
        for (int i = 0; i < 16; ++i) o[e][i] *= inv;
    bf16* Y = ((bf16*)(F.ws + WS_YCAT)) + (size_t)(qrow + r) * DM + ocol;
    if (MODE == 0) {
        LAS float* cmb = (LAS float*)(lds + L_CMB) + (size_t)sub * 64 * 64;
        __syncthreads();
        if (w & 1) {
#pragma unroll
            for (int e = 0; e < NEB; ++e)
#pragma unroll
                for (int i = 0; i < 16; ++i) cmb[(e * 16 + i) * 64 + lane] = o[e][i];
        }
        __syncthreads();
        if (!(w & 1)) {
            const float lam = ((float*)(F.ws + WS_LAM))[layer * 4 + 0], oml = ((float*)(F.ws + WS_LAM))[layer * 4 + 1];
            float ss = 0.f;
#pragma unroll
            for (int e = 0; e < NEB; ++e)
#pragma unroll
                for (int i = 0; i < 16; ++i) { const float d = o[e][i] - lam * cmb[(e * 16 + i) * 64 + lane]; o[e][i] = d; ss += d * d; }
            ss += __shfl_xor(ss, 32);
            const float sc = oml / sqrtf(ss * (1.0f / 128.0f) + LN_EPS);
#pragma unroll
            for (int e = 0; e < NEB; ++e)
#pragma unroll
                for (int g = 0; g < 4; ++g)
                    *(GAS unsigned long long*)(Y + 32 * e + 8 * g + 4 * h) = (unsigned long long)cvt2(o[e][4 * g] * sc, o[e][4 * g + 1] * sc) | ((unsigned long long)cvt2(o[e][4 * g + 2] * sc, o[e][4 * g + 3] * sc) << 32);
        }
    } else {
#pragma unroll
        for (int e = 0; e < NEB; ++e)
#pragma unroll
            for (int g = 0; g < 4; ++g)
                *(GAS unsigned long long*)(Y + 32 * e + 8 * g + 4 * h) = (unsigned long long)cvt2(o[e][4 * g], o[e][4 * g + 1]) | ((unsigned long long)cvt2(o[e][4 * g + 2], o[e][4 * g + 3]) << 32);
    }
    __syncthreads();
}

__device__ __forceinline__ void bmix_unit(Frame& F, const Args& A, int n, int layer) {
    constexpr int VNP = 272;
    const int tid = F.tid, lane = F.lane, w = F.wave, r = lane & 31, h = lane >> 5;
    LAS unsigned char* lds = F.lds + RING_OFF;
    LAS float* stats = (LAS float*)(lds + 36864);
    const bf16* PROJ = ((bf16*)(F.ws + WS_PROJ)); const int row0 = 128 * n;
    const float* gng = A.in[15] + layer * 512; const float* gnb = A.in[16] + layer * 512;
    __syncthreads();
    for (int rr = 0; rr < 16; ++rr) {
        const v4u p = *(const GAS v4u*)(PROJ + (size_t)(row0 + 16 * w + rr) * DPROJ + C_BV + 8 * lane);
        float v[8] = {bf_lo(p.x), bf_hi(p.x), bf_lo(p.y), bf_hi(p.y), bf_lo(p.z), bf_hi(p.z), bf_lo(p.w), bf_hi(p.w)};
        float s = 0.f;
#pragma unroll
        for (int i = 0; i < 8; ++i) s += v[i];
        const float mean = wave_sum(s) * (1.0f / 512.0f); float s2 = 0.f;
#pragma unroll
        for (int i = 0; i < 8; ++i) { const float d = v[i] - mean; s2 += d * d; }
        const float rstd = 1.0f / sqrtf(wave_sum(s2) * (1.0f / 512.0f) + LN_EPS);
        if (lane == 0) { stats[(16 * w + rr) * 2] = mean; stats[(16 * w + rr) * 2 + 1] = rstd; }
    }
    __syncthreads();
    for (int g = 0; g < 4; ++g) {
        { const int q = tid & 127, cg = tid >> 7; const float mean = stats[q * 2], rstd = stats[q * 2 + 1];
#pragma unroll
          for (int i4 = 0; i4 < 4; ++i4) {
            const int cb = 128 * g + 32 * cg + 8 * i4;
            const v4u p = *(const GAS v4u*)(PROJ + (size_t)(row0 + q) * DPROJ + C_BV + cb);
            const float v[8] = {bf_lo(p.x), bf_hi(p.x), bf_lo(p.y), bf_hi(p.y), bf_lo(p.z), bf_hi(p.z), bf_lo(p.w), bf_hi(p.w)};
#pragma unroll
            for (int i = 0; i < 8; ++i) { const float y = (v[i] - mean) * rstd * gng[cb + i] + gnb[cb + i];
                *(LAS bf16*)(lds + (32 * cg + 8 * i4 + i) * VNP + 2 * q) = (bf16)f2bf(y); }
          } }
        __syncthreads();
        const int pb = w & 3; const bf16* Wg = ((bf16*)(F.ws + WS_WSP)) + (size_t)(layer * 4 + g) * 128 * 128;
        f32x16 d[2];
#pragma unroll
        for (int j = 0; j < 2; ++j)
#pragma unroll
            for (int i = 0; i < 16; ++i) d[j][i] = 0.f;
#pragma unroll
        for (int s = 0; s < 8; ++s) {
            const bf16x8 bw = *(const GAS bf16x8*)(Wg + (size_t)(32 * pb + r) * 128 + 16 * s + 8 * h);
#pragma unroll
            for (int j = 0; j < 2; ++j) { const int cb = 2 * (w >> 2) + j;
                const bf16x8 av = *(const LAS bf16x8*)(lds + (32 * cb + r) * VNP + (16 * s + 8 * h) * 2);
                d[j] = MFMA32(av, bw, d[j]); }
        }
        const int row = row0 + 32 * pb + r; const float bsv = A.in[18][(size_t)(layer * 4 + g) * 128 + 32 * pb + r];
#pragma unroll
        for (int j = 0; j < 2; ++j) { const int cb = 2 * (w >> 2) + j;
#pragma unroll
            for (int gq = 0; gq < 4; ++gq) { const int c = 128 * g + 32 * cb + 8 * gq + 4 * h;
                const unsigned long long up = *(const GAS unsigned long long*)(PROJ + (size_t)row * DPROJ + C_BU + c);
                const unsigned ulo = (unsigned)up, uhi = (unsigned)(up >> 32);
                const float o0 = bf_lo(ulo) * (d[j][4 * gq] + bsv), o1 = bf_hi(ulo) * (d[j][4 * gq + 1] + bsv), o2 = bf_lo(uhi) * (d[j][4 * gq + 2] + bsv), o3 = bf_hi(uhi) * (d[j][4 * gq + 3] + bsv);
                *(GAS unsigned long long*)(((bf16*)(F.ws + WS_YCAT)) + (size_t)row * DM + 512 + c) = (unsigned long long)cvt2(o0, o1) | ((unsigned long long)cvt2(o2, o3) << 32); } }
        __syncthreads();
    }
}

#ifndef MK_SINGLE
#define MK_SINGLE 0
#endif
constexpr int N_PHASES = 2 + 8 * 3 + 4 * 4;
__global__ void __launch_bounds__(NTHREADS, 2) mega_fwd(Args args) {
    extern __shared__ __attribute__((aligned(16))) unsigned char lds_raw[];
    Frame F;
    F.lds = (LAS unsigned char*)lds_raw;
    const int wave0 = __builtin_amdgcn_readfirstlane((int)threadIdx.x >> 6);
#define PH_BEGIN() do { int w_ = wave0; asm volatile("" : "+s"(w_)); int l_ = (int)__builtin_amdgcn_mbcnt_hi(~0u, __builtin_amdgcn_mbcnt_lo(~0u, 0u)); asm volatile("" : "+v"(l_)); F.wave = w_; F.lane = l_; F.tid = w_ * 64 + l_; \
        int b_ = (int)blockIdx.x; asm volatile("" : "+s"(b_)); F.bid = b_; F.gw = b_ * NWAVES + w_; unsigned char* p_ = args.ws; asm volatile("" : "+s"(p_)); F.ws = p_; } while (0)
    F.G = gridDim.x; F.ngw = F.G * NWAVES;
    PH_BEGIN();
    const Args& A = args;
    for (int u = F.tid; u < (LDS_BYTES - LDSCTL_OFF) / 4; u += NTHREADS) ((LAS unsigned*)(F.lds + LDSCTL_OFF))[u] = 0u;
    __syncthreads();
    const int lo = args.ph_lo, hi = args.ph_hi;
    const bool multi = (hi - lo) > 1;
    XcdBarrier bar; bar.bar = (unsigned*)(F.ws + WS_CTL) + CW_BAR; bar.x = 0; bar.st = nullptr;
    if (multi) bar = xcd_barrier_post((unsigned*)(F.ws + WS_CTL) + CW_BAR, (volatile LAS unsigned*)(F.lds + MISC_OFF) + 8);
    int pc = 0;
#define IN_PH() (lo <= pc && pc < hi)
#define SEAM() do { if (lo <= pc && pc + 1 < hi) xcd_barrier(bar); ++pc; } while (0)
#define WSF(off) ((float*)(F.ws + (off)))
#define WSB(off) ((bf16*)(F.ws + (off)))

    if (IN_PH()) { PH_BEGIN(); asm volatile("; MARK1" ::: "memory"); p0a(F, A); } SEAM();
    if (IN_PH()) { PH_BEGIN(); asm volatile("; MARK2" ::: "memory"); p0b(F, A); } SEAM();

    for (int seg = 0; seg < 2 * NLAYER; ++seg) {
        const int l = seg >> 1, second = seg & 1; const bool last = (l == NLAYER - 1);
        const int mrows = (last && second) ? SEQ : MTOT;
#define WL() (WSB(WS_W) + (size_t)l * (W_LAYER / 2))
#define MOD_LAT() (WSF(WS_MOD) + (size_t)(l * 2 + 0) * MODW)
#define MOD_CTX() (WSF(WS_MOD) + (size_t)(l * 2 + 1) * MODW)
        if (IN_PH()) { PH_BEGIN(); asm volatile("; MARK3" ::: "memory");
            pg8::Gemm g{WSB(WS_XM), WL() + (second ? W_2IN : W_1IN) / 2, mrows, 2 * DFF, DM}; pg8::StaticOrder S; S.init(mrows, 2 * DFF, F.G, F.bid);
            pg8::EpiSwiGLU E{WSB(WS_H), DFF};
            pg8::gemm_phase<pg8::EpiSwiGLU, pg8::StaticOrder, true, true>(F.lds + RING_OFF, g, S, E, F.tid);
        } SEAM();
        if (IN_PH()) { PH_BEGIN(); asm volatile("; MARK4" ::: "memory");
            pg8::Gemm g{WSB(WS_H), WL() + (second ? W_2OUT : W_1OUT) / 2, mrows, DM, DFF}; pg8::StaticOrder S; S.init(mrows, DM, F.G, F.bid);
            const int gi = second ? 8 : 2;
            pg8::EpiRes E{WSF(WS_X), DM, MOD_LAT() + gi * DM, MOD_CTX() + gi * DM, 0.5f, ALPHA, SEQ / 256};
            pg8::gemm_phase<pg8::EpiRes, pg8::StaticOrder, true, true>(F.lds + RING_OFF, g, S, E, F.tid);
        } SEAM();
        if (IN_PH()) { PH_BEGIN(); asm volatile("; MARK5" ::: "memory");
            const int lni = second ? 2 : 0;
            const float* g = A.in[6] + (size_t)(l * 3 + lni) * DM; const float* b = A.in[7] + (size_t)(l * 3 + lni) * DM;
            const bool fin = second && last;
            const int lm = (second && !last) ? l + 1 : l;
            ln_pass(F, A, g, b, WSF(WS_MOD) + (size_t)(lm * 2) * MODW, WSF(WS_MOD) + (size_t)(lm * 2 + 1) * MODW, second ? 0 : 3, second ? 1 : 4, mrows, fin ? A.out : nullptr);
        } SEAM();
        if (!second) {
            if (IN_PH()) { PH_BEGIN(); asm volatile("; MARK6" ::: "memory");
                pg8::Gemm g{WSB(WS_XM), WL() + W_MI / 2, MTOT, DPROJ, DM}; pg8::StaticOrder S; S.init(MTOT, DPROJ, F.G, F.bid);
                pg8::EpiProj E{WSB(WS_PROJ), DPROJ, WSF(WS_ROPE), WSF(WS_ROPE) + 4096, WSF(WS_ROPE) + 8192, WSF(WS_ROPE) + 9216, SEQ, QS};
                pg8::gemm_phase<pg8::EpiProj, pg8::StaticOrder, true, true>(F.lds + RING_OFF, g, S, E, F.tid);
            } SEAM();
            if (IN_PH()) { PH_BEGIN(); asm volatile("; MARK7" ::: "memory");
                const int n_lat = 512 * 3 + 128, n_all = last ? n_lat : n_lat + 26;
                for (int u = F.bid; u < n_all; u += F.G) { PH_BEGIN();
                    int mode, ui; bool cx = false;
                    if (u < 512) { mode = 0; ui = u; } else if (u < 1024) { mode = 1; ui = u - 512; } else if (u < 1536) { mode = 2; ui = u - 1024; } else if (u < 1664) { mode = 3; ui = u - 1536; }
                    else if (u < 1672) { mode = 0; ui = u - 1664; cx = true; } else if (u < 1680) { mode = 1; ui = u - 1672; cx = true; } else if (u < 1688) { mode = 2; ui = u - 1680; cx = true; } else { mode = 3; ui = 128 + (u - 1688); }
                    if (mode == 0) attn_unit<0>(F, A, ui, cx, l);
                    else if (mode == 1) attn_unit<1>(F, A, ui, cx, l);
                    else if (mode == 2) attn_unit<2>(F, A, ui, cx, l);
                    else bmix_unit(F, A, ui, l);
                }
            } SEAM();
            { const int mr2 = last ? SEQ : MTOT;
            if (IN_PH()) { PH_BEGIN(); asm volatile("; MARK8" ::: "memory");
                pg8::Gemm g{WSB(WS_YCAT), WL() + W_MO / 2, mr2, DM, DM}; pg8::StaticOrder S; S.init(mr2, DM, F.G, F.bid);
                pg8::EpiRes E{WSF(WS_X), DM, MOD_LAT() + 5 * DM, MOD_CTX() + 5 * DM, 1.0f, ALPHA, SEQ / 256};
                pg8::gemm_phase<pg8::EpiRes, pg8::StaticOrder, true, true>(F.lds + RING_OFF, g, S, E, F.tid);
            } SEAM();
            if (IN_PH()) { PH_BEGIN(); asm volatile("; MARK9" ::: "memory");
                const float* g = A.in[6] + (size_t)(l * 3 + 1) * DM; const float* b = A.in[7] + (size_t)(l * 3 + 1) * DM;
                ln_pass(F, A, g, b, MOD_LAT(), MOD_CTX(), 6, 7, mr2, nullptr);
            } SEAM(); }
        }
    }
#undef IN_PH
#undef SEAM
}

extern "C" void kernel_launch(void* const* d_in, const int* in_sizes, int n_in, void* d_out, int out_size, void* d_ws, size_t ws_size, hipStream_t stream) {
    static int grid = 0;
    if (grid == 0) {
        if (n_in != 21 || in_sizes[0] != SEQ * DM || out_size != SEQ * DM || ws_size < WS_END) { fprintf(stderr, "kernel_launch: unexpected shapes (n_in %d, in0 %d, out %d, ws %zu); nothing launched\n", n_in, n_in > 0 ? in_sizes[0] : -1, out_size, ws_size); grid = -1; return; }
        int dev = 0, cus = 0, per_cu = 0;
        if (hipGetDevice(&dev) != hipSuccess || hipDeviceGetAttribute(&cus, hipDeviceAttributeMultiprocessorCount, dev) != hipSuccess) { grid = -1; return; }
        if (hipFuncSetAttribute((const void*)mega_fwd, hipFuncAttributeMaxDynamicSharedMemorySize, LDS_BYTES) != hipSuccess) { fprintf(stderr, "kernel_launch: hipFuncSetAttribute failed\n"); grid = -1; return; }
        if (hipOccupancyMaxActiveBlocksPerMultiprocessor(&per_cu, (const void*)mega_fwd, NTHREADS, LDS_BYTES) != hipSuccess || per_cu < 1) fprintf(stderr, "kernel_launch: occupancy query reports %d\n", per_cu);
        (void)hipGetLastError();
        grid = cus;
    }
    if (grid < 0) return;
    if (hipMemsetAsync((char*)d_ws + WS_CTL, 0, CTL_ZERO_BYTES, stream) != hipSuccess) return;
    Args a{};
    for (int i = 0; i < 21; ++i) a.in[i] = (const float*)d_in[i];
    a.out = (float*)d_out; a.ws = (unsigned char*)d_ws;
#if MK_SINGLE
    a.ph_lo = 0; a.ph_hi = N_PHASES;
    hipLaunchKernelGGL(mega_fwd, dim3(grid), dim3(NTHREADS), LDS_BYTES, stream, a);
#else
    for (int p = 0; p < N_PHASES; ++p) { a.ph_lo = p; a.ph_hi = p + 1; hipLaunchKernelGGL(mega_fwd, dim3(grid), dim3(NTHREADS), LDS_BYTES, stream, a); }
#endif
}
```

```cpp
#include <hip/hip_runtime.h>
#include <hip/hip_bf16.h>
#include <cstdio>
#include <cstdint>
#include <cmath>
namespace pg8 {
#define PG8_LAS __attribute__((address_space(3)))
typedef unsigned short bf16_t;
typedef short bf16x8 __attribute__((ext_vector_type(8)));
typedef float f32x4 __attribute__((ext_vector_type(4)));
typedef unsigned u32x4 __attribute__((ext_vector_type(4)));
constexpr int BM = 256, BK = 64, HALF = 128, HTB = HALF * BK * 2  , STAGE_BYTES = 8 * HTB, NXCD = 8, WGM = 8;

__host__ __device__ __forceinline__ int lds_byte(int r, int c) { const int st = (r >> 4) * 2 + (c >> 5), rr = r & 15, cc = c & 31, ob = rr * 64 + cc * 2; return st * 1024 + (ob ^ (((ob >> 9) & 1) << 5)); }
__host__ __device__ __forceinline__ void stage_rc(int b, int& R, int& C) { const int st = b / 1024, sb = b % 1024, swz = sb ^ (((sb >> 9) & 1) << 5); R = (st >> 1) * 16 + swz / 64; C = (st & 1) * 32 + (swz % 64) / 2; }
__host__ __device__ __forceinline__ int perm32(int rho) { const int n = rho >> 4, i = rho & 15; return 8 * (i >> 2) + 4 * n + (i & 3); }

struct Unit { int pm, pn; };
struct Gemm { const bf16_t* A; const bf16_t* Bt; int M, N, K; };

struct StaticOrder {
    int nM, nN, nwg, G, c;
    __host__ __device__ void init(int M, int N, int G_, int c_) { nM = M / BM; nN = N / BM; nwg = nM * nN; G = G_; c = c_; }
    __host__ __device__ bool next(int i, Unit& u) const {
        const long L = (long)i * G + c; if (L >= nwg) return false;
        int wgid = (int)L; { const int q = nwg / NXCD, r = nwg % NXCD, xcd = wgid % NXCD, off = wgid / NXCD; wgid = (xcd < r ? xcd * (q + 1) : r * (q + 1) + (xcd - r) * q) + off; }
        const int nig = WGM * nN, gid = wgid / nig, fm = gid * WGM, gsz = (nM - fm) < WGM ? (nM - fm) : WGM;
        u.pm = fm + ((wgid % nig) % gsz); u.pn = (wgid % nig) / gsz; return true;
    }
    __device__ __forceinline__ void a_ready(const Unit&) const {}
    __device__ __forceinline__ void done(const Unit&) const {}
};

__device__ __forceinline__ unsigned cvt_pk_bf16(float lo, float hi) { unsigned r; asm volatile("v_cvt_pk_bf16_f32 %0, %1, %2" : "=v"(r) : "v"(lo), "v"(hi)); return r; }
typedef float f32x2 __attribute__((ext_vector_type(2)));
__device__ __forceinline__ float silu_f(float x) { return x * __builtin_amdgcn_rcpf(1.0f + __builtin_amdgcn_exp2f(-1.4426950408889634f * x)); }
__device__ __forceinline__ float gelu_tanh_f(float x) { const float z2 = -2.0f * 1.4426950408889634f * 0.7978845608028654f * (x + 0.044715f * x * x * x); return x * __builtin_amdgcn_rcpf(1.0f + __builtin_amdgcn_exp2f(z2)); }

struct EpiSwiGLU {
    static constexpr bool PERM = true, AFTER_DRAIN = false;
    bf16_t* H; int ldh;
    __device__ __forceinline__ void operator()(const f32x4 (&acc)[2][2][4][2], const Unit& u, int wr, int wc, int fr, int fq) const {
        const int row0 = u.pm * BM + wr * 64 + fr, col0 = u.pn * HALF + wc * 32 + 8 * fq;
#pragma unroll
        for (int ai = 0; ai < 2; ++ai)
#pragma unroll
            for (int m = 0; m < 4; ++m) { bf16_t* rowp = H + (size_t)(row0 + ai * HALF + m * 16) * ldh + col0;
                const f32x4 g0 = acc[ai][0][m][0], g1 = acc[ai][0][m][1], u0 = acc[ai][1][m][0], u1 = acc[ai][1][m][1];
                u32x4 w;
                w.x = cvt_pk_bf16(silu_f(g0[0]) * u0[0], silu_f(g0[1]) * u0[1]); w.y = cvt_pk_bf16(silu_f(g0[2]) * u0[2], silu_f(g0[3]) * u0[3]);
                w.z = cvt_pk_bf16(silu_f(g1[0]) * u1[0], silu_f(g1[1]) * u1[1]); w.w = cvt_pk_bf16(silu_f(g1[2]) * u1[2], silu_f(g1[3]) * u1[3]);
                *(u32x4*)rowp = w; }
    }
};

struct EpiRes {
    static constexpr bool PERM = false, AFTER_DRAIN = false;
    float* X; int ldx; const float* gate_lat; const float* gate_ctx; float gscale, alpha; int ctx_pm;
    __device__ __forceinline__ void operator()(const f32x4 (&acc)[2][2][4][2], const Unit& u, int wr, int wc, int fr, int fq) const {
        const float* gp = (u.pm >= ctx_pm) ? gate_ctx : gate_lat;
        const int col0 = u.pn * BM + wc * 32 + 4 * fq;
        f32x4 gv[2][2];
#pragma unroll
        for (int bj = 0; bj < 2; ++bj)
#pragma unroll
            for (int n = 0; n < 2; ++n) gv[bj][n] = *(const f32x4*)(gp + col0 + bj * HALF + n * 16) * gscale;
#pragma unroll
        for (int ai = 0; ai < 2; ++ai)
#pragma unroll
            for (int m = 0; m < 4; ++m) { float* xp = X + (size_t)(u.pm * BM + ai * HALF + wr * 64 + m * 16 + fr) * ldx + col0;
#pragma unroll
                for (int bj = 0; bj < 2; ++bj)
#pragma unroll
                    for (int n = 0; n < 2; ++n) { f32x4 x = *(const f32x4*)(xp + bj * HALF + n * 16); x = x * alpha + gv[bj][n] * acc[ai][bj][m][n]; *(f32x4*)(xp + bj * HALF + n * 16) = x; } }
    }
};

struct EpiProj {
    static constexpr bool PERM = true, AFTER_DRAIN = false;
    bf16_t* P; int ldp; const float* cosR; const float* sinR; const float* cosC; const float* sinC; int seq; float qs;
    __device__ __forceinline__ void operator()(const f32x4 (&acc)[2][2][4][2], const Unit& u, int wr, int wc, int fr, int fq) const {
        const int row0 = u.pm * BM + wr * 64 + fr;
#pragma unroll
        for (int bj = 0; bj < 2; ++bj) {
            const int hc = u.pn * BM + bj * HALF;
            int mode = 0; float sc = 1.0f;
            if (hc < 512) { mode = 1; sc = qs; } else if (hc < 1024) { mode = 1; } else if (hc < 1536) { mode = 0; } else if (hc < 2560) { mode = 2; }
            else if (hc < 3072) { mode = 1; sc = qs; } else if (hc < 3200) { mode = 1; } else if (hc < 3328) { mode = 0; } else if (hc < 3840) { mode = 0; sc = qs; }
            const float* ct = (wc & 1) ? cosC : cosR; const float* st = (wc & 1) ? sinC : sinR;
#pragma unroll
            for (int ai = 0; ai < 2; ++ai)
#pragma unroll
                for (int m = 0; m < 4; ++m) { const int row = row0 + ai * HALF + m * 16;
                    f32x4 v0 = acc[ai][bj][m][0], v1 = acc[ai][bj][m][1];
                    if (mode == 1) { if (row < seq) { const int pos = (wc & 1) ? (row & 63) : (row >> 6);
                            const f32x4 c = *(const f32x4*)(ct + pos * 16 + 4 * fq), s = *(const f32x4*)(st + pos * 16 + 4 * fq);
                            const f32x4 o0 = v0 * c - v1 * s, o1 = v0 * s + v1 * c; v0 = o0; v1 = o1; } }
                    else if (mode == 2) { v0 = (f32x4){gelu_tanh_f(v0[0]), gelu_tanh_f(v0[1]), gelu_tanh_f(v0[2]), gelu_tanh_f(v0[3])}; v1 = (f32x4){gelu_tanh_f(v1[0]), gelu_tanh_f(v1[1]), gelu_tanh_f(v1[2]), gelu_tanh_f(v1[3])}; }
                    v0 = v0 * sc; v1 = v1 * sc;
                    u32x4 w; w.x = cvt_pk_bf16(v0[0], v0[1]); w.y = cvt_pk_bf16(v0[2], v0[3]); w.z = cvt_pk_bf16(v1[0], v1[1]); w.w = cvt_pk_bf16(v1[2], v1[3]);
                    *(u32x4*)(P + (size_t)row * ldp + hc + wc * 32 + 8 * fq) = w; }
        }
    }
};
template <class Epi, class Sched, bool ALIGN_EPI = false, bool SP2 = false>
__device__ __forceinline__ void gemm_phase(PG8_LAS unsigned char* lds, const Gemm g, const Sched& S, const Epi& E, const int tid) {
    const int wid = __builtin_amdgcn_readfirstlane(tid >> 6), lane = tid & 63, wr = wid >> 2, wc = wid & 3, fr = lane & 15, fq = lane >> 4;
    const int K = g.K, nt = K / BK;
    unsigned voffA[2], voffB[2];
#pragma unroll
    for (int i = 0; i < 2; ++i) { int R, C; stage_rc(tid * 16 + i * 8192, R, C); const int Rb = Epi::PERM ? ((R & ~31) + perm32(R & 31)) : R;
        voffA[i] = (unsigned)(R * K + C) * 2u; voffB[i] = (unsigned)(Rb * K + C) * 2u; }
    const size_t kstep = (size_t)(BK * 2);
    const size_t hstep = (size_t)HALF * K * 2;
    const size_t tstep = 2 * hstep;
    const unsigned ldsw = (unsigned)wid * 1024u;
    const int aoff = lds_byte(wr * 64 + fr, fq * 8), boff = lds_byte(wc * 32 + fr, fq * 8);
#define PG8_SA(b, h) (((b) * 2 + (h)) * HTB)
#define PG8_SB(b, h) ((4 + (b) * 2 + (h)) * HTB)
#define PG8_STAGE(bufoff, gbase, voff) do { _Pragma("unroll") for (int _i = 0; _i < 2; ++_i) \
        __builtin_amdgcn_global_load_lds((const unsigned*)((const char*)(gbase) + (voff)[_i]), (PG8_LAS unsigned*)(lds + (bufoff) + ldsw + _i * 8192), 16, 0, 0); } while (0)
#define PG8_LDA(dst, b, h) do { _Pragma("unroll") for (int m = 0; m < 4; ++m) _Pragma("unroll") for (int k = 0; k < 2; ++k) dst[m][k] = *(const PG8_LAS bf16x8*)(lds + PG8_SA(b, h) + aoff + m * 2048 + k * 1024); } while (0)
#define PG8_LDB(dst, b, h) do { _Pragma("unroll") for (int n = 0; n < 2; ++n) _Pragma("unroll") for (int k = 0; k < 2; ++k) dst[n][k] = *(const PG8_LAS bf16x8*)(lds + PG8_SB(b, h) + boff + n * 2048 + k * 1024); } while (0)
#define PG8_MMA(ai, bj, At, Bt) do { __builtin_amdgcn_s_setprio(1); _Pragma("unroll") for (int m = 0; m < 4; ++m) _Pragma("unroll") for (int n = 0; n < 2; ++n) _Pragma("unroll") for (int k = 0; k < 2; ++k) \
        acc[ai][bj][m][n] = __builtin_amdgcn_mfma_f32_16x16x32_bf16(Bt[n][k], At[m][k], acc[ai][bj][m][n], 0, 0, 0); __builtin_amdgcn_s_setprio(0); } while (0)
#define PG8_WAIT_V(n) asm volatile("s_waitcnt vmcnt(" #n ")" ::: "memory")
#define PG8_WAIT_L(n) asm volatile("s_waitcnt lgkmcnt(" #n ")" ::: "memory")
#define PG8_BAR __builtin_amdgcn_s_barrier()
#define PG8_SCHED __builtin_amdgcn_sched_barrier(0)
    Unit cur, nxt; int ui = 0;
    if (!S.next(0, cur)) return;
    f32x4 acc[2][2][4][2];
#pragma unroll
    for (int a = 0; a < 2; ++a)
#pragma unroll
        for (int b = 0; b < 2; ++b)
#pragma unroll
            for (int m = 0; m < 4; ++m)
#pragma unroll
                for (int n = 0; n < 2; ++n) acc[a][b][m][n] = (f32x4){0.f, 0.f, 0.f, 0.f};
    bf16x8 At[4][2], B0[2][2], B1[2][2];
    const char* cA = (const char*)g.A + (size_t)cur.pm * tstep; const char* cB = (const char*)g.Bt + (size_t)cur.pn * tstep;
    S.a_ready(cur);
    if constexpr (SP2) {
        PG8_STAGE(PG8_SB(0, 0), cB, voffB); PG8_STAGE(PG8_SB(0, 1), cB + hstep, voffB); PG8_STAGE(PG8_SA(0, 0), cA, voffA); PG8_STAGE(PG8_SA(0, 1), cA + hstep, voffA);
        if (wr == 1) PG8_BAR;
        PG8_WAIT_V(2); PG8_BAR;
        PG8_STAGE(PG8_SB(1, 0), cB + kstep, voffB); PG8_STAGE(PG8_SA(1, 0), cA + kstep, voffA); PG8_STAGE(PG8_SB(1, 1), cB + hstep + kstep, voffB);
        PG8_WAIT_V(6); PG8_BAR;
    } else {
        PG8_STAGE(PG8_SB(0, 0), cB, voffB); PG8_STAGE(PG8_SA(0, 0), cA, voffA); PG8_STAGE(PG8_SB(0, 1), cB + hstep, voffB); PG8_STAGE(PG8_SA(0, 1), cA + hstep, voffA);
        if (wr == 1) PG8_BAR;
        PG8_WAIT_V(4); PG8_BAR;
        PG8_STAGE(PG8_SB(1, 0), cB + kstep, voffB); PG8_STAGE(PG8_SA(1, 0), cA + kstep, voffA); PG8_STAGE(PG8_SB(1, 1), cB + hstep + kstep, voffB);
        PG8_WAIT_V(6); PG8_BAR;
    }
    for (;;) {
        const bool has_next = S.next(ui + 1, nxt);
        const char* nA = has_next ? (const char*)g.A + (size_t)nxt.pm * tstep : cA; const char* nB = has_next ? (const char*)g.Bt + (size_t)nxt.pn * tstep : cB;
        for (int t = 0; t < nt; t += 2) {
            const bool last = (t == nt - 2);
            const char* a1 = cA + (size_t)(t + 1) * kstep;
            const char* a2 = last ? nA : cA + (size_t)(t + 2) * kstep; const char* b2 = last ? nB : cB + (size_t)(t + 2) * kstep;
            const char* a3 = a2 + kstep; const char* b3 = b2 + kstep;
            if (last && has_next) S.a_ready(nxt);
            if constexpr (SP2) {
            PG8_LDB(B0, 0, 0); PG8_LDB(B1, 0, 1); PG8_SCHED; PG8_LDA(At, 0, 0); PG8_STAGE(PG8_SA(1, 1), a1 + hstep, voffA);
            PG8_WAIT_V(8); PG8_WAIT_L(0); PG8_BAR; PG8_MMA(0, 0, At, B0); PG8_MMA(0, 1, At, B1); PG8_BAR; PG8_SCHED;
            PG8_LDA(At, 0, 1); PG8_STAGE(PG8_SB(0, 0), b2, voffB); PG8_STAGE(PG8_SB(0, 1), b2 + hstep, voffB); PG8_STAGE(PG8_SA(0, 0), a2, voffA);
            PG8_WAIT_V(8); PG8_WAIT_L(0); PG8_BAR; PG8_MMA(1, 0, At, B0); PG8_MMA(1, 1, At, B1); PG8_BAR; PG8_SCHED;
            PG8_LDB(B0, 1, 0); PG8_LDB(B1, 1, 1); PG8_SCHED; PG8_LDA(At, 1, 0); PG8_STAGE(PG8_SA(0, 1), a2 + hstep, voffA);
            PG8_WAIT_V(8); PG8_WAIT_L(0); PG8_BAR; PG8_MMA(0, 0, At, B0); PG8_MMA(0, 1, At, B1); PG8_BAR; PG8_SCHED;
            PG8_LDA(At, 1, 1); PG8_STAGE(PG8_SB(1, 0), b3, voffB); PG8_STAGE(PG8_SB(1, 1), b3 + hstep, voffB); PG8_STAGE(PG8_SA(1, 0), a3, voffA);
            PG8_WAIT_V(8); PG8_WAIT_L(0); PG8_BAR; PG8_MMA(1, 0, At, B0); PG8_MMA(1, 1, At, B1); PG8_BAR; PG8_SCHED;
            } else {
            PG8_LDB(B0, 0, 0); PG8_SCHED; PG8_LDA(At, 0, 0); PG8_STAGE(PG8_SA(1, 1), a1 + hstep, voffA);
            PG8_WAIT_L(8); PG8_BAR; PG8_WAIT_L(0); PG8_MMA(0, 0, At, B0); PG8_BAR; PG8_SCHED;
            PG8_LDB(B1, 0, 1); PG8_STAGE(PG8_SB(0, 0), b2, voffB);
            PG8_BAR; PG8_WAIT_L(0); PG8_MMA(0, 1, At, B1); PG8_BAR;
            PG8_LDA(At, 0, 1); PG8_STAGE(PG8_SA(0, 0), a2, voffA);
            PG8_BAR; PG8_WAIT_L(0); PG8_MMA(1, 0, At, B0); PG8_BAR; PG8_SCHED;
            PG8_STAGE(PG8_SB(0, 1), b2 + hstep, voffB);
            PG8_WAIT_V(6); PG8_BAR; PG8_MMA(1, 1, At, B1); PG8_BAR;
            PG8_LDB(B0, 1, 0); PG8_SCHED; PG8_LDA(At, 1, 0); PG8_STAGE(PG8_SA(0, 1), a2 + hstep, voffA);
            PG8_WAIT_L(8); PG8_BAR; PG8_WAIT_L(0); PG8_MMA(0, 0, At, B0); PG8_BAR; PG8_SCHED;
            PG8_LDB(B1, 1, 1); PG8_STAGE(PG8_SB(1, 0), b3, voffB);
            PG8_BAR; PG8_WAIT_L(0); PG8_MMA(0, 1, At, B1); PG8_BAR;
            PG8_LDA(At, 1, 1); PG8_STAGE(PG8_SA(1, 0), a3, voffA);
            PG8_BAR; PG8_WAIT_L(0); PG8_MMA(1, 0, At, B0); PG8_BAR; PG8_SCHED;
            PG8_STAGE(PG8_SB(1, 1), b3 + hstep, voffB);
            PG8_WAIT_V(6); PG8_BAR; PG8_MMA(1, 1, At, B1); PG8_BAR;
            }
        }
        if constexpr (ALIGN_EPI) { if (wr == 0) PG8_BAR; }
        if constexpr (!Epi::AFTER_DRAIN) { E(acc, cur, wr, wc, fr, fq); S.done(cur); }
        if (!has_next) break;
#pragma unroll
        for (int a = 0; a < 2; ++a)
#pragma unroll
            for (int b = 0; b < 2; ++b)
#pragma unroll
                for (int m = 0; m < 4; ++m)
#pragma unroll
                    for (int n = 0; n < 2; ++n) acc[a][b][m][n] = (f32x4){0.f, 0.f, 0.f, 0.f};
        cur = nxt; cA = nA; cB = nB; ++ui;
        if constexpr (ALIGN_EPI) { if (wr == 1) PG8_BAR; }
    }
    PG8_WAIT_V(0);
    if constexpr (!ALIGN_EPI) { if (wr == 0) PG8_BAR; }
    PG8_BAR;
    if constexpr (Epi::AFTER_DRAIN) { E.fused(acc, cur, wr, wc, fr, fq, lds, wid, lane); S.done(cur); }
#undef PG8_SA
#undef PG8_SB
#undef PG8_STAGE
#undef PG8_LDA
#undef PG8_LDB
#undef PG8_MMA
#undef PG8_WAIT_V
#undef PG8_WAIT_L
#undef PG8_BAR
#undef PG8_SCHED
}
}
#define GAS __attribute__((address_space(1)))
#define LAS __attribute__((address_space(3)))
typedef unsigned short bf16;
typedef unsigned v4u __attribute__((ext_vector_type(4)));
typedef float f32x4 __attribute__((ext_vector_type(4)));
typedef short bf16x8 __attribute__((ext_vector_type(8)));
typedef GAS unsigned gu32;
typedef GAS unsigned long long gu64;
#define RLX_AGENT __ATOMIC_RELAXED, __HIP_MEMORY_SCOPE_AGENT
#define LDS_WAIT() asm volatile("s_waitcnt lgkmcnt(0)" ::: "memory")
#define VM_WAIT() asm volatile("s_waitcnt vmcnt(0)" ::: "memory")
__device__ __forceinline__ unsigned long long rt() { return __builtin_amdgcn_s_memrealtime(); }
__device__ __forceinline__ unsigned f2bf(float f) { unsigned u = __builtin_bit_cast(unsigned, f); return (u + 0x7fffu + ((u >> 16) & 1u)) >> 16; }
__device__ __forceinline__ unsigned pk2(float lo, float hi) { return f2bf(lo) | (f2bf(hi) << 16); }

#define XB_TMO      128
#define XB_XCNT(j)  (256  + 64 * (j))
#define XB_XSUB(j)  (1280 + 64 * (j))
#define XB_XGEN(j)  (2304 + 64 * (j))
#define XB_TOP      3328
#define XB_TOPGEN   3392
#define XCD_BAR_WORDS 3456
#define XB_SPIN_CAP (1u << 18)

__device__ __forceinline__ unsigned xb_ld(unsigned* p)              { return __hip_atomic_load(p, __ATOMIC_RELAXED, __HIP_MEMORY_SCOPE_AGENT); }
__device__ __forceinline__ unsigned xb_add(unsigned* p, unsigned v) { return __hip_atomic_fetch_add(p, v, __ATOMIC_RELAXED, __HIP_MEMORY_SCOPE_AGENT); }
__device__ __forceinline__ unsigned xb_xcc_id() { return (unsigned)__builtin_amdgcn_s_getreg((3 << 11) | 20) & 0xFu; }
#define XB_SPIN(cond, bar) do { unsigned _sp = 0; while (cond) { __builtin_amdgcn_s_sleep(1); \
    if ((++_sp & 255u) == 0u) { if (xb_ld(&(bar)[XB_TMO])) break; if (_sp > XB_SPIN_CAP) { atomicAdd(&(bar)[XB_TMO], 1u); break; } } } } while (0)

struct XcdBarrier {
    unsigned* bar; unsigned x;
    volatile LAS unsigned* st;
};

__device__ __forceinline__ XcdBarrier xcd_barrier_post(unsigned* bar, volatile LAS unsigned* st) {
    XcdBarrier b; b.bar = bar; b.x = xb_xcc_id(); b.st = st;
    if (threadIdx.x == 0) (void)xb_add(&bar[XB_XCNT(b.x)], 1u);
    return b;
}
__device__ __forceinline__ void xcd_barrier_complete(unsigned* bar, unsigned x, unsigned& nloc, unsigned& nx) {
    const unsigned G = gridDim.x * gridDim.y * gridDim.z;
    unsigned sum, cnt, mine, sp = 0u;
    for (;;) {
        sum = 0u; cnt = 0u; mine = 0u;
#pragma unroll
        for (unsigned j = 0; j < 16; ++j) { const unsigned c = xb_ld(&bar[XB_XCNT(j)]); sum += c; cnt += (c > 0u) ? 1u : 0u; mine = (j == x) ? c : mine; }
        if (sum == G) break;
        __builtin_amdgcn_s_sleep(1);
        if ((++sp & 255u) == 0u) { if (xb_ld(&bar[XB_TMO])) break; if (sp > XB_SPIN_CAP) { atomicAdd(&bar[XB_TMO], 1u); break; } }
    }
    nloc = mine > 0u ? mine : 1u; nx = cnt > 0u ? cnt : 1u;
}

__device__ __forceinline__ void xcd_barrier(const XcdBarrier& b) {
    asm volatile("s_waitcnt vmcnt(0)" ::: "memory");
    __syncthreads();
    if (threadIdx.x == 0) {
        unsigned* bar = b.bar;
        __builtin_amdgcn_s_waitcnt(0);
        unsigned nloc = b.st[0], nx = b.st[1];
        if (nloc == 0u) { xcd_barrier_complete(bar, b.x, nloc, nx); b.st[0] = nloc; b.st[1] = nx; }
        const unsigned old = xb_add(&bar[XB_XSUB(b.x)], 1u);
        const unsigned gen = old / nloc;
        if (old + 1u == (gen + 1u) * nloc) {
            __builtin_amdgcn_fence(__ATOMIC_RELEASE, "agent");
            asm volatile("s_waitcnt vmcnt(0)" ::: "memory");
            const unsigned og = xb_add(&bar[XB_TOP], 1u);
            const unsigned tg = og / nx;
            if (og + 1u == (tg + 1u) * nx) xb_add(&bar[XB_TOPGEN], 1u);
            else XB_SPIN(xb_ld(&bar[XB_TOPGEN]) == tg, bar);
            __builtin_amdgcn_fence(__ATOMIC_ACQUIRE, "agent");
            xb_add(&bar[XB_XGEN(b.x)], 1u);
            asm volatile("s_waitcnt vmcnt(0)" ::: "memory");
        } else {
            XB_SPIN(xb_ld(&bar[XB_XGEN(b.x)]) == gen, bar);
            __builtin_amdgcn_fence(__ATOMIC_ACQUIRE, "agent");
            asm volatile("s_waitcnt vmcnt(0)" ::: "memory");
        }
    }
    __syncthreads();
}

constexpr int DM = 2048, SEQ = 16384, CTXL = 256, MTOT = SEQ + CTXL, NLAYER = 4, DFF = 5632, DPROJ = 4864, NMOD = 9, MODW = NMOD * DM;
constexpr int NWAVES = 8, NTHREADS = NWAVES * 64;
constexpr float LN_EPS = 1e-6f, ALPHA = 1.681792830507429f, LOG2E = 1.4426950408889634f, QS = 0.125f * LOG2E;
constexpr int C_AQ = 0, C_AK = 512, C_AV = 1024, C_BU = 1536, C_BV = 2048, C_CQ = 2560, C_CK = 3072, C_CV = 3200, C_DQ = 3328, C_DK = 3840, C_DV = 4352;

constexpr size_t MiB = 1u << 20;
constexpr size_t WS_CTL = 0, CTL_ZERO_BYTES = 1 * MiB;
constexpr size_t WS_MOD = 1 * MiB;
constexpr size_t WS_LAM = WS_MOD + 640 * 1024;
constexpr size_t WS_ROPE = WS_MOD + 704 * 1024;
constexpr size_t WS_WSP = 3 * MiB;
constexpr size_t WS_W = 4 * MiB;
constexpr size_t W_1IN = 0, W_1OUT = 44 * MiB, W_2IN = 66 * MiB, W_2OUT = 110 * MiB, W_MI = 132 * MiB, W_MO = 151 * MiB, W_LAYER = 159 * MiB;
constexpr size_t WS_X = 640 * MiB;
constexpr size_t WS_XM = 770 * MiB;
constexpr size_t WS_H = 835 * MiB;
constexpr size_t WS_PROJ = 1014 * MiB;
constexpr size_t WS_YCAT = 1169 * MiB;
constexpr size_t WS_END = 1234 * MiB;
static_assert(WS_W + NLAYER * W_LAYER <= WS_X && WS_X + (size_t)MTOT * DM * 4 <= WS_XM && WS_XM + (size_t)MTOT * DM * 2 <= WS_H && WS_H + (size_t)MTOT * DFF * 2 <= WS_PROJ &&
              WS_PROJ + (size_t)MTOT * DPROJ * 2 <= WS_YCAT && WS_YCAT + (size_t)MTOT * DM * 2 <= WS_END, "d_ws map");
constexpr int CW_TMO = 0, CW_BAR = 4096;
constexpr int RING_OFF = 0, RING_BYTES = 131072;
constexpr int LDSCTL_OFF = RING_BYTES, MISC_OFF = LDSCTL_OFF + 320;
constexpr int LDS_BYTES = 147456;

struct Args { const float* in[21]; float* out; unsigned char* ws; int ph_lo, ph_hi; };
struct Frame {
    LAS unsigned char* lds;
    unsigned char* ws;
    int tid, lane, wave, G, gw, ngw, bid;
};
__device__ __forceinline__ float wave_sum(float v) {
#pragma unroll
    for (int o = 1; o < 64; o <<= 1) v += __shfl_xor(v, o);
    return v;
}
__device__ __forceinline__ unsigned cvt2(float lo, float hi) { typedef float f2 __attribute__((ext_vector_type(2))); typedef __bf16 b2 __attribute__((ext_vector_type(2))); f2 v = {lo, hi}; b2 b = __builtin_convertvector(v, b2); return __builtin_bit_cast(unsigned, b); }
__device__ __forceinline__ float bf_lo(unsigned w) { return __uint_as_float(w << 16); }
__device__ __forceinline__ float bf_hi(unsigned w) { return __uint_as_float(w & 0xffff0000u); }

__device__ const float ROPE_INV[16] = {1.000000000e+00f, 5.623413324e-01f, 3.162277639e-01f, 1.778279394e-01f, 1.000000015e-01f, 5.623413250e-02f, 3.162277490e-02f, 1.778279431e-02f,
                                       9.999999776e-03f, 5.623413250e-03f, 3.162277630e-03f, 1.778279431e-03f, 1.000000047e-03f, 5.623413017e-04f, 3.162277571e-04f, 1.778279402e-04f};

__device__ __forceinline__ int map_dest(int mapk, int n) {
    if (mapk == 1) { const int s = n >= DFF ? 1 : 0, hid = n - s * DFF; return (hid >> 7) * 256 + s * 128 + (hid & 127); }
    if (mapk == 2) { const bool rope = (n < C_AV) || (n >= C_CQ && n < C_CV); if (rope) { const int d = n & 63; return (n & ~63) + 32 * ((d >> 4) & 1) + 8 * ((d >> 2) & 3) + 4 * (d >> 5) + (d & 3); } }
    return n;
}
__device__ __forceinline__ void transpose_item(const float* W, int K, int N, bf16* WT, int mapk, LAS float* scr, int item, int lane) {
    const int nblk = N / 32, kb = item / nblk, nb = item % nblk, k0 = 64 * kb, n0 = 32 * nb;
#pragma unroll 8
    for (int i = 0; i < 32; ++i) { const int kk = 2 * i + (lane >> 5); scr[kk * 33 + (lane & 31)] = W[(size_t)(k0 + kk) * N + n0 + (lane & 31)]; }
    LDS_WAIT(); asm volatile("" ::: "memory");
    const int c = lane & 7;
#pragma unroll
    for (int j = 0; j < 4; ++j) { const int n = (lane >> 3) + 8 * j; const LAS float* s = scr + (8 * c) * 33 + n;
        v4u o; o.x = pk2(s[0 * 33], s[1 * 33]); o.y = pk2(s[2 * 33], s[3 * 33]); o.z = pk2(s[4 * 33], s[5 * 33]); o.w = pk2(s[6 * 33], s[7 * 33]);
        *(GAS v4u*)(WT + (size_t)map_dest(mapk, n0 + n) * K + k0 + 8 * c) = o; }
    LDS_WAIT(); asm volatile("" ::: "memory");
}
__device__ __forceinline__ void sincos_acc(float ang, float& s, float& c) {
    const double x = (double)ang, k = __builtin_rint(x * 0.15915494309189535);
    const double y = (x - k * 6.283185307179586) - k * 2.4492935982947064e-16, y2 = y * y;
    double ts = y, ss = y, tc = 1.0, cs = 1.0;
    for (int n = 1; n <= 14; ++n) { tc *= -y2 / (double)((2 * n - 1) * (2 * n)); cs += tc; ts *= -y2 / (double)((2 * n) * (2 * n + 1)); ss += ts; }
    s = (float)ss; c = (float)cs;
}
__device__ __forceinline__ float silu_s(float x) { return x / (1.0f + __expf(-x)); }

__device__ __forceinline__ void p0a(Frame& F, const Args& A) {
    LAS float* sc = (LAS float*)(F.lds + RING_OFF); LAS float* scc = sc + DM; LAS float* red = sc + 2 * DM;
    for (int i = F.tid; i < DM; i += NTHREADS) { sc[i] = silu_s(A.in[1][i]); scc[i] = silu_s(A.in[3][i]); }
    __syncthreads();
    { const int cq = F.tid & 15, ks = F.tid >> 4;
      for (int it = F.bid; it < NLAYER * (MODW / 64); it += F.G) {
        const int l = it / (MODW / 64), jg = it % (MODW / 64);
        const float* Wl = A.in[4] + (size_t)l * DM * MODW + 64 * jg + 4 * cq + (size_t)(ks * 64) * MODW;
        f32x4 ax = {0.f, 0.f, 0.f, 0.f}, ac = {0.f, 0.f, 0.f, 0.f};
#pragma unroll 8
        for (int kk = 0; kk < 64; ++kk) { const f32x4 w = *(const GAS f32x4*)(Wl + (size_t)kk * MODW); ax += w * sc[ks * 64 + kk]; ac += w * scc[ks * 64 + kk]; }
        LAS float* rp = red + (ks * 16 + cq) * 8;
        rp[0] = ax[0]; rp[1] = ax[1]; rp[2] = ax[2]; rp[3] = ax[3]; rp[4] = ac[0]; rp[5] = ac[1]; rp[6] = ac[2]; rp[7] = ac[3];
        __syncthreads();
        if (F.tid < 128) { const int cq2 = F.tid & 15, comp = F.tid >> 4; float s = 0.f;
            for (int k2 = 0; k2 < 32; ++k2) s += red[(k2 * 16 + cq2) * 8 + comp];
            const int j = 64 * jg + 4 * cq2 + (comp & 3), ty = comp >> 2;
            ((float*)(F.ws + WS_MOD))[(size_t)(l * 2 + ty) * MODW + j] = s + A.in[5][(size_t)l * MODW + j]; }
        __syncthreads();
      } }
    { LAS float* scr = (LAS float*)(F.lds + RING_OFF + F.wave * 16384);
      constexpr int I_IN = (DM / 64) * (2 * DFF / 32), I_OUT = (DFF / 64) * (DM / 32), I_MI = (DM / 64) * (DPROJ / 32), I_MO = (DM / 64) * (DM / 32), I_L = 2 * I_IN + 2 * I_OUT + I_MI + I_MO;
      for (int it = F.gw; it < NLAYER * I_L; it += F.ngw) {
        const int l = it / I_L; int r = it % I_L; bf16* Wl = ((bf16*)(F.ws + WS_W)) + (size_t)l * (W_LAYER / 2);
        if (r < I_IN) { transpose_item(A.in[8] + (size_t)l * DM * 2 * DFF, DM, 2 * DFF, Wl + W_1IN / 2, 1, scr, r, F.lane); continue; } r -= I_IN;
        if (r < I_OUT) { transpose_item(A.in[9] + (size_t)l * DFF * DM, DFF, DM, Wl + W_1OUT / 2, 0, scr, r, F.lane); continue; } r -= I_OUT;
        if (r < I_IN) { transpose_item(A.in[10] + (size_t)l * DM * 2 * DFF, DM, 2 * DFF, Wl + W_2IN / 2, 1, scr, r, F.lane); continue; } r -= I_IN;
        if (r < I_OUT) { transpose_item(A.in[11] + (size_t)l * DFF * DM, DFF, DM, Wl + W_2OUT / 2, 0, scr, r, F.lane); continue; } r -= I_OUT;
        if (r < I_MI) { transpose_item(A.in[12] + (size_t)l * DM * DPROJ, DM, DPROJ, Wl + W_MI / 2, 2, scr, r, F.lane); continue; } r -= I_MI;
        transpose_item(A.in[13] + (size_t)l * DM * DM, DM, DM, Wl + W_MO / 2, 0, scr, r, F.lane);
      } }
    { const int gt = F.bid * NTHREADS + F.tid, ngt = F.G * NTHREADS;
      for (int e = gt; e < 320 * 16; e += ngt) { const int pos = e >> 4, f = e & 15; float s, c;
        if (pos < 256) { sincos_acc((float)pos * ROPE_INV[f], s, c); ((float*)(F.ws + WS_ROPE))[pos * 16 + f] = c; ((float*)(F.ws + WS_ROPE))[4096 + pos * 16 + f] = s; }
        else { const int p2 = pos - 256; sincos_acc((float)p2 * ROPE_INV[f], s, c); ((float*)(F.ws + WS_ROPE))[8192 + p2 * 16 + f] = c; ((float*)(F.ws + WS_ROPE))[9216 + p2 * 16 + f] = s; } }
      for (int e = gt; e < NLAYER * 4 * 128 * 128; e += ngt) ((bf16*)(F.ws + WS_WSP))[e] = (bf16)f2bf(A.in[17][e]);
      if (gt < NLAYER) { const float* lv = A.in[14] + gt * 256; float s01 = 0.f, s23 = 0.f;
        for (int i = 0; i < 64; ++i) { s01 += lv[i] * lv[64 + i]; s23 += lv[128 + i] * lv[192 + i]; }
        const float li = 0.8f - 0.6f * expf(-0.3f * (float)gt);
        ((float*)(F.ws + WS_LAM))[gt * 4 + 0] = expf(s01) - expf(s23) + li; ((float*)(F.ws + WS_LAM))[gt * 4 + 1] = 1.0f - li; } }
}
__device__ __forceinline__ void p0b(Frame& F, const Args& A) {
    for (int row = F.gw; row < MTOT; row += F.ngw) {
        const float* src = row < SEQ ? A.in[0] + (size_t)row * DM : A.in[2] + (size_t)(row - SEQ) * DM;
        const float* mod = ((float*)(F.ws + WS_MOD)) + (size_t)(row >= SEQ ? 1 : 0) * MODW;
#pragma unroll
        for (int j = 0; j < 8; ++j) { const int idx = (F.lane + 64 * j) * 4;
            const f32x4 v = *(const GAS f32x4*)(src + idx), sh = *(const GAS f32x4*)(mod + idx), sc = *(const GAS f32x4*)(mod + DM + idx);
            *(GAS f32x4*)(((float*)(F.ws + WS_X)) + (size_t)row * DM + idx) = v;
            const f32x4 o = v * (sc + 1.0f) + sh;
            *(GAS unsigned long long*)(((bf16*)(F.ws + WS_XM)) + (size_t)row * DM + idx) = (unsigned long long)cvt2(o[0], o[1]) | ((unsigned long long)cvt2(o[2], o[3]) << 32); }
    }
}
__device__ __forceinline__ void ln_pass(Frame& F, const Args& A, const float* g, const float* b, const float* mod_lat, const float* mod_ctx, int ish, int isc, int nrows, float* fin) {
    for (int row = F.gw; row < nrows; row += F.ngw) {
        float* xr = ((float*)(F.ws + WS_X)) + (size_t)row * DM; f32x4 v[8]; float s = 0.f;
#pragma unroll
        for (int j = 0; j < 8; ++j) { v[j] = *(const GAS f32x4*)(xr + (F.lane + 64 * j) * 4); s += (v[j][0] + v[j][1]) + (v[j][2] + v[j][3]); }
        const float mean = wave_sum(s) * (1.0f / DM); float s2 = 0.f;
#pragma unroll
        for (int j = 0; j < 8; ++j) { v[j] = v[j] - mean; s2 += (v[j][0] * v[j][0] + v[j][1] * v[j][1]) + (v[j][2] * v[j][2] + v[j][3] * v[j][3]); }
        const float rstd = 1.0f / sqrtf(wave_sum(s2) * (1.0f / DM) + LN_EPS);
        const float* mod = row >= SEQ ? mod_ctx : mod_lat;
#pragma unroll
        for (int j = 0; j < 8; ++j) { const int idx = (F.lane + 64 * j) * 4;
            const f32x4 gg = *(const GAS f32x4*)(g + idx), bb = *(const GAS f32x4*)(b + idx);
            const f32x4 xn = v[j] * rstd * gg + bb;
            if (fin) { *(GAS f32x4*)(fin + (size_t)row * DM + idx) = xn; }
            else { *(GAS f32x4*)(xr + idx) = xn;
                const f32x4 sh = *(const GAS f32x4*)(mod + ish * DM + idx), sc = *(const GAS f32x4*)(mod + isc * DM + idx);
                const f32x4 o = xn * (sc + 1.0f) + sh;
                *(GAS unsigned long long*)(((bf16*)(F.ws + WS_XM)) + (size_t)row * DM + idx) = (unsigned long long)cvt2(o[0], o[1]) | ((unsigned long long)cvt2(o[2], o[3]) << 32); } }
    }
}

typedef float f32x16 __attribute__((ext_vector_type(16)));
typedef short s16x4 __attribute__((ext_vector_type(4)));
typedef short v4i16_t __attribute__((ext_vector_type(4)));
__device__ __forceinline__ int crow(int i, int h) { return (i & 3) + 8 * (i >> 2) + 4 * h; }
__device__ __forceinline__ s16x4 vtr(LAS const unsigned char* p) { return __builtin_bit_cast(s16x4, __builtin_amdgcn_ds_read_tr16_b64_v4i16((LAS v4i16_t*)p)); }
#define MFMA32(a, b, c) __builtin_amdgcn_mfma_f32_32x32x16_bf16((a), (b), (c), 0, 0, 0)
constexpr int L_K = 0, L_V = 17408, L_CMB = 40960, L_BIAS = 106496;

template <int MODE>
__device__ __forceinline__ void attn_unit(Frame& F, const Args& A, int uidx, bool is_ctx, int layer) {
    constexpr int KD = (MODE == 0) ? 128 : 64, NCH = KD / 64, KP = KD * 2 + 16, VP = KD * 2 + 64, NEB = KD / 32;
    const int tid = F.tid, lane = F.lane, w = F.wave, r = lane & 31, h = lane >> 5;
    LAS unsigned char* lds = F.lds + RING_OFF;
    const bf16* PROJ = ((bf16*)(F.ws + WS_PROJ));
    int qrow, qcol, kcol0, vcol0, kcl = 0, nctx, nb0, nt, ocol;
    int gr = 0, my_rs = 0, sub = 0;
    float sink2 = 0.f;
    if (MODE == 0) {
        const int head = uidx & 3, qb = uidx >> 2; sub = w >> 1; const int comp = w & 1;
        qrow = (is_ctx ? SEQ : 0) + 128 * qb + 32 * sub; qcol = C_AQ + 128 * head + 64 * comp; kcol0 = C_AK + 128 * head; vcol0 = C_AV + 128 * head; kcl = 64 * comp;
        if (is_ctx) { nctx = 4; nb0 = 0; nt = 4; } else { nctx = 0; nb0 = 0; nt = MTOT / 64; }
        ocol = 128 * head;
    } else if (MODE == 1) {
        const int kv = uidx & 1, qb = uidx >> 1; const int g = w >> 1; sub = w & 1; const int head = 4 * kv + g;
        qrow = (is_ctx ? SEQ : 0) + 64 * qb + 32 * sub; qcol = C_CQ + 64 * head; kcol0 = C_CK + 64 * kv; vcol0 = C_CV + 64 * kv;
        nctx = 4;
        if (is_ctx) { nb0 = 0; nt = 4; } else { const int b0 = qb - 2 < 0 ? 0 : qb - 2, b1 = qb + 2 > 255 ? 255 : qb + 2; nb0 = b0; nt = 4 + (b1 - b0 + 1); }
        ocol = 1024 + 64 * head;
        sink2 = A.in[19][layer * 8 + head] * LOG2E;
    } else {
        const int head = uidx & 7, rg = uidx >> 3;
        qcol = C_DQ + 64 * head; kcol0 = C_DK + 64 * head; vcol0 = C_DV + 64 * head; nctx = 4; ocol = 1536 + 64 * head;
        if (is_ctx) { qrow = SEQ + 32 * w; nb0 = 0; nt = 4; }
        else { gr = 4 * rg + (w >> 1); qrow = 64 * gr + 32 * (w & 1);
            int lo = 4 * rg - 4; lo = lo < 0 ? 0 : (lo > 248 ? 248 : lo); int hi = 4 * rg + 3 - 4; hi = hi < 0 ? 0 : (hi > 248 ? 248 : hi); hi += 7;
            nb0 = lo; nt = 4 + (hi - lo + 1); my_rs = gr - 4; my_rs = my_rs < 0 ? 0 : (my_rs > 248 ? 248 : my_rs);
            LAS float* bl = (LAS float*)(lds + L_BIAS);
            for (int i = tid; i < 15 * 31; i += NTHREADS) bl[i] = A.in[20][(size_t)(layer * 8 + head) * 465 + i] * LOG2E; }
    }
    bf16x8 qf[4];
#pragma unroll
    for (int s = 0; s < 4; ++s) qf[s] = *(const GAS bf16x8*)(PROJ + (size_t)(qrow + r) * DPROJ + qcol + 16 * s + 8 * h);
    f32x16 o[NEB];
#pragma unroll
    for (int e = 0; e < NEB; ++e)
#pragma unroll
        for (int i = 0; i < 16; ++i) o[e][i] = 0.f;
    float m_run = -1e30f, l_run = 0.f;
    v4u kreg[NCH], vreg[NCH];
#define TILE_ROW(t) (((t) < nctx) ? (SEQ + 64 * (t)) : 64 * (nb0 + (t) - nctx))
#define TILE_GLOAD(t) do { const int rb_ = TILE_ROW(t); _Pragma("unroll") for (int i_ = 0; i_ < NCH; ++i_) { const int c_ = tid + NTHREADS * i_, row_ = c_ / (KD / 8), cc_ = c_ % (KD / 8); \
        kreg[i_] = *(const GAS v4u*)(PROJ + (size_t)(rb_ + row_) * DPROJ + kcol0 + 8 * cc_); vreg[i_] = *(const GAS v4u*)(PROJ + (size_t)(rb_ + row_) * DPROJ + vcol0 + 8 * cc_); } } while (0)
#define TILE_LSTORE() do { _Pragma("unroll") for (int i_ = 0; i_ < NCH; ++i_) { const int c_ = tid + NTHREADS * i_, row_ = c_ / (KD / 8), cc_ = c_ % (KD / 8); \
        *(LAS v4u*)(lds + L_K + row_ * KP + cc_ * 16) = kreg[i_]; *(LAS v4u*)(lds + L_V + row_ * VP + cc_ * 16) = vreg[i_]; } } while (0)
    TILE_GLOAD(0);
    const int li = lane & 15, lblk = (lane >> 4) & 1;
    for (int t = 0; t < nt; ++t) {
        __syncthreads();
        TILE_LSTORE();
        __syncthreads();
        if (t + 1 < nt) TILE_GLOAD(t + 1);
        bool active = true;
        int kr = 0;
        if (MODE == 2 && t >= nctx) { kr = nb0 + t - nctx; active = (kr >= my_rs) && (kr <= my_rs + 7); }
        if (active) {
            f32x16 s0, s1;
#pragma unroll
            for (int i = 0; i < 16; ++i) { s0[i] = 0.f; s1[i] = 0.f; }
#pragma unroll
            for (int s = 0; s < 4; ++s) {
                const bf16x8 k0 = *(const LAS bf16x8*)(lds + L_K + r * KP + (kcl + 16 * s + 8 * h) * 2);
                const bf16x8 k1 = *(const LAS bf16x8*)(lds + L_K + (32 + r) * KP + (kcl + 16 * s + 8 * h) * 2);
                s0 = MFMA32(k0, qf[s], s0); s1 = MFMA32(k1, qf[s], s1);
            }
            if (MODE == 1 && t >= nctx) {
                const int rb = TILE_ROW(t), qt = qrow + r;
#pragma unroll
                for (int i = 0; i < 16; ++i) { const int k0t = rb + crow(i, h), d0 = k0t - qt, d1 = d0 + 32;
                    if (d0 > 128 || d0 < -128) s0[i] = -INFINITY; if (d1 > 128 || d1 < -128) s1[i] = -INFINITY; }
            }
            if (MODE == 2 && t >= nctx) {
                const int qc = (qrow & 63) + r; int cs = qc - 8; cs = cs < 0 ? 0 : (cs > 48 ? 48 : cs);
                const LAS float* bl = (const LAS float*)(lds + L_BIAS) + (kr - gr + 7) * 31 + 15 - qc;
#pragma unroll
                for (int i = 0; i < 16; ++i) { const int kc0 = crow(i, h), kc1 = kc0 + 32;
                    s0[i] = (kc0 >= cs && kc0 < cs + 16) ? s0[i] + bl[kc0] : -INFINITY;
                    s1[i] = (kc1 >= cs && kc1 < cs + 16) ? s1[i] + bl[kc1] : -INFINITY; }
            }
            float mx = s0[0];
#pragma unroll
            for (int i = 1; i < 16; ++i) mx = fmaxf(mx, s0[i]);
#pragma unroll
            for (int i = 0; i < 16; ++i) mx = fmaxf(mx, s1[i]);
            mx = fmaxf(mx, __shfl_xor(mx, 32));
            const float m_new = fmaxf(m_run, mx), alpha = __builtin_amdgcn_exp2f(m_run - m_new);
            m_run = m_new;
            float ls = 0.f;
#pragma unroll
            for (int i = 0; i < 16; ++i) { s0[i] = __builtin_amdgcn_exp2f(s0[i] - m_new); s1[i] = __builtin_amdgcn_exp2f(s1[i] - m_new); ls += s0[i] + s1[i]; }
            l_run = l_run * alpha + ls;
#pragma unroll
            for (int e = 0; e < NEB; ++e)
#pragma unroll
                for (int i = 0; i < 16; ++i) o[e][i] *= alpha;
            bf16x8 pf[2][2];
#pragma unroll
            for (int s = 0; s < 2; ++s) {
                v4u a, b;
                a.x = cvt2(s0[8 * s + 0], s0[8 * s + 1]); a.y = cvt2(s0[8 * s + 2], s0[8 * s + 3]); a.z = cvt2(s0[8 * s + 4], s0[8 * s + 5]); a.w = cvt2(s0[8 * s + 6], s0[8 * s + 7]);
                b.x = cvt2(s1[8 * s + 0], s1[8 * s + 1]); b.y = cvt2(s1[8 * s + 2], s1[8 * s + 3]); b.z = cvt2(s1[8 * s + 4], s1[8 * s + 5]); b.w = cvt2(s1[8 * s + 6], s1[8 * s + 7]);
                pf[0][s] = __builtin_bit_cast(bf16x8, a); pf[1][s] = __builtin_bit_cast(bf16x8, b);
            }
#pragma unroll
            for (int kb = 0; kb < 2; ++kb)
#pragma unroll
                for (int s = 0; s < 2; ++s)
#pragma unroll
                    for (int e = 0; e < NEB; ++e) {
                        LAS const unsigned char* vp = lds + L_V + (32 * kb + 16 * s + 4 * h + (li >> 2)) * VP + (32 * e + 16 * lblk) * 2 + 8 * (li & 3);
                        const s16x4 lo = vtr(vp), hi = vtr(vp + 8 * VP);
                        const bf16x8 vf = {lo[0], lo[1], lo[2], lo[3], hi[0], hi[1], hi[2], hi[3]};
                        o[e] = MFMA32(vf, pf[kb][s], o[e]);
                    }
        }
    }
#undef TILE_ROW
#undef TILE_GLOAD
#undef TILE_LSTORE
    float l_tot = l_run + __shfl_xor(l_run, 32);
    if (MODE == 1) l_tot += __builtin_amdgcn_exp2f(sink2 - m_run);
    const float inv = 1.0f / l_tot;
#pragma unroll
    for (int e = 0; e < NEB; ++e)
#pragma unroll
        for (int i = 0; i < 16; ++i) o[e][i] *= inv;
    bf16* Y = ((bf16*)(F.ws + WS_YCAT)) + (size_t)(qrow + r) * DM + ocol;
    if (MODE == 0) {
        LAS float* cmb = (LAS float*)(lds + L_CMB) + (size_t)sub * 64 * 64;
        __syncthreads();
        if (w & 1) {
#pragma unroll
            for (int e = 0; e < NEB; ++e)
#pragma unroll
                for (int i = 0; i < 16; ++i) cmb[(e * 16 + i) * 64 + lane] = o[e][i];
        }
        __syncthreads();
        if (!(w & 1)) {
            const float lam = ((float*)(F.ws + WS_LAM))[layer * 4 + 0], oml = ((float*)(F.ws + WS_LAM))[layer * 4 + 1];
            float ss = 0.f;
#pragma unroll
            for (int e = 0; e < NEB; ++e)
#pragma unroll
                for (int i = 0; i < 16; ++i) { const float d = o[e][i] - lam * cmb[(e * 16 + i) * 64 + lane]; o[e][i] = d; ss += d * d; }
            ss += __shfl_xor(ss, 32);
            const float sc = oml / sqrtf(ss * (1.0f / 128.0f) + LN_EPS);
#pragma unroll
            for (int e = 0; e < NEB; ++e)
#pragma unroll
                for (int g = 0; g < 4; ++g)
                    *(GAS unsigned long long*)(Y + 32 * e + 8 * g + 4 * h) = (unsigned long long)cvt2(o[e][4 * g] * sc, o[e][4 * g + 1] * sc) | ((unsigned long long)cvt2(o[e][4 * g + 2] * sc, o[e][4 * g + 3] * sc) << 32);
        }
    } else {
#pragma unroll
        for (int e = 0; e < NEB; ++e)
#pragma unroll
            for (int g = 0; g < 4; ++g)
                *(GAS unsigned long long*)(Y + 32 * e + 8 * g + 4 * h) = (unsigned long long)cvt2(o[e][4 * g], o[e][4 * g + 1]) | ((unsigned long long)cvt2(o[e][4 * g + 2], o[e][4 * g + 3]) << 32);
    }
    __syncthreads();
}

__device__ __forceinline__ void bmix_unit(Frame& F, const Args& A, int n, int layer) {
    constexpr int VNP = 272;
    const int tid = F.tid, lane = F.lane, w = F.wave, r = lane & 31, h = lane >> 5;
    LAS unsigned char* lds = F.lds + RING_OFF;
    LAS float* stats = (LAS float*)(lds + 36864);
    const bf16* PROJ = ((bf16*)(F.ws + WS_PROJ)); const int row0 = 128 * n;
    const float* gng = A.in[15] + layer * 512; const float* gnb = A.in[16] + layer * 512;
    __syncthreads();
    for (int rr = 0; rr < 16; ++rr) {
        const v4u p = *(const GAS v4u*)(PROJ + (size_t)(row0 + 16 * w + rr) * DPROJ + C_BV + 8 * lane);
        float v[8] = {bf_lo(p.x), bf_hi(p.x), bf_lo(p.y), bf_hi(p.y), bf_lo(p.z), bf_hi(p.z), bf_lo(p.w), bf_hi(p.w)};
        float s = 0.f;
#pragma unroll
        for (int i = 0; i < 8; ++i) s += v[i];
        const float mean = wave_sum(s) * (1.0f / 512.0f); float s2 = 0.f;
#pragma unroll
        for (int i = 0; i < 8; ++i) { const float d = v[i] - mean; s2 += d * d; }
        const float rstd = 1.0f / sqrtf(wave_sum(s2) * (1.0f / 512.0f) + LN_EPS);
        if (lane == 0) { stats[(16 * w + rr) * 2] = mean; stats[(16 * w + rr) * 2 + 1] = rstd; }
    }
    __syncthreads();
    for (int g = 0; g < 4; ++g) {
        { const int q = tid & 127, cg = tid >> 7; const float mean = stats[q * 2], rstd = stats[q * 2 + 1];
#pragma unroll
          for (int i4 = 0; i4 < 4; ++i4) {
            const int cb = 128 * g + 32 * cg + 8 * i4;
            const v4u p = *(const GAS v4u*)(PROJ + (size_t)(row0 + q) * DPROJ + C_BV + cb);
            const float v[8] = {bf_lo(p.x), bf_hi(p.x), bf_lo(p.y), bf_hi(p.y), bf_lo(p.z), bf_hi(p.z), bf_lo(p.w), bf_hi(p.w)};
#pragma unroll
            for (int i = 0; i < 8; ++i) { const float y = (v[i] - mean) * rstd * gng[cb + i] + gnb[cb + i];
                *(LAS bf16*)(lds + (32 * cg + 8 * i4 + i) * VNP + 2 * q) = (bf16)f2bf(y); }
          } }
        __syncthreads();
        const int pb = w & 3; const bf16* Wg = ((bf16*)(F.ws + WS_WSP)) + (size_t)(layer * 4 + g) * 128 * 128;
        f32x16 d[2];
#pragma unroll
        for (int j = 0; j < 2; ++j)
#pragma unroll
            for (int i = 0; i < 16; ++i) d[j][i] = 0.f;
#pragma unroll
        for (int s = 0; s < 8; ++s) {
            const bf16x8 bw = *(const GAS bf16x8*)(Wg + (size_t)(32 * pb + r) * 128 + 16 * s + 8 * h);
#pragma unroll
            for (int j = 0; j < 2; ++j) { const int cb = 2 * (w >> 2) + j;
                const bf16x8 av = *(const LAS bf16x8*)(lds + (32 * cb + r) * VNP + (16 * s + 8 * h) * 2);
                d[j] = MFMA32(av, bw, d[j]); }
        }
        const int row = row0 + 32 * pb + r; const float bsv = A.in[18][(size_t)(layer * 4 + g) * 128 + 32 * pb + r];
#pragma unroll
        for (int j = 0; j < 2; ++j) { const int cb = 2 * (w >> 2) + j;
#pragma unroll
            for (int gq = 0; gq < 4; ++gq) { const int c = 128 * g + 32 * cb + 8 * gq + 4 * h;
                const unsigned long long up = *(const GAS unsigned long long*)(PROJ + (size_t)row * DPROJ + C_BU + c);
                const unsigned ulo = (unsigned)up, uhi = (unsigned)(up >> 32);
                const float o0 = bf_lo(ulo) * (d[j][4 * gq] + bsv), o1 = bf_hi(ulo) * (d[j][4 * gq + 1] + bsv), o2 = bf_lo(uhi) * (d[j][4 * gq + 2] + bsv), o3 = bf_hi(uhi) * (d[j][4 * gq + 3] + bsv);
                *(GAS unsigned long long*)(((bf16*)(F.ws + WS_YCAT)) + (size_t)row * DM + 512 + c) = (unsigned long long)cvt2(o0, o1) | ((unsigned long long)cvt2(o2, o3) << 32); } }
        __syncthreads();
    }
}

#ifndef MK_SINGLE
#define MK_SINGLE 1
#endif
constexpr int N_PHASES = 2 + 8 * 3 + 4 * 4;
__global__ void __launch_bounds__(NTHREADS, 2) mega_fwd(Args args) {
    extern __shared__ __attribute__((aligned(16))) unsigned char lds_raw[];
    Frame F;
    F.lds = (LAS unsigned char*)lds_raw;
    const int wave0 = __builtin_amdgcn_readfirstlane((int)threadIdx.x >> 6);
#define PH_BEGIN() do { int w_ = wave0; asm volatile("" : "+s"(w_)); int l_ = (int)__builtin_amdgcn_mbcnt_hi(~0u, __builtin_amdgcn_mbcnt_lo(~0u, 0u)); asm volatile("" : "+v"(l_)); F.wave = w_; F.lane = l_; F.tid = w_ * 64 + l_; \
        int b_ = (int)blockIdx.x; asm volatile("" : "+s"(b_)); F.bid = b_; F.gw = b_ * NWAVES + w_; unsigned char* p_ = args.ws; asm volatile("" : "+s"(p_)); F.ws = p_; } while (0)
    F.G = gridDim.x; F.ngw = F.G * NWAVES;
    PH_BEGIN();
    const Args& A = args;
    for (int u = F.tid; u < (LDS_BYTES - LDSCTL_OFF) / 4; u += NTHREADS) ((LAS unsigned*)(F.lds + LDSCTL_OFF))[u] = 0u;
    __syncthreads();
    const int lo = args.ph_lo, hi = args.ph_hi;
    const bool multi = (hi - lo) > 1;
    XcdBarrier bar; bar.bar = (unsigned*)(F.ws + WS_CTL) + CW_BAR; bar.x = 0; bar.st = nullptr;
    if (multi) bar = xcd_barrier_post((unsigned*)(F.ws + WS_CTL) + CW_BAR, (volatile LAS unsigned*)(F.lds + MISC_OFF) + 8);
    int pc = 0;
#define IN_PH() (lo <= pc && pc < hi)
#define SEAM() do { if (lo <= pc && pc + 1 < hi) xcd_barrier(bar); ++pc; } while (0)
#define WSF(off) ((float*)(F.ws + (off)))
#define WSB(off) ((bf16*)(F.ws + (off)))

    if (IN_PH()) { PH_BEGIN(); asm volatile("; MARK1" ::: "memory"); p0a(F, A); } SEAM();
    if (IN_PH()) { PH_BEGIN(); asm volatile("; MARK2" ::: "memory"); p0b(F, A); } SEAM();

    for (int seg = 0; seg < 2 * NLAYER; ++seg) {
        const int l = seg >> 1, second = seg & 1; const bool last = (l == NLAYER - 1);
        const int mrows = (last && second) ? SEQ : MTOT;
#define WL() (WSB(WS_W) + (size_t)l * (W_LAYER / 2))
#define MOD_LAT() (WSF(WS_MOD) + (size_t)(l * 2 + 0) * MODW)
#define MOD_CTX() (WSF(WS_MOD) + (size_t)(l * 2 + 1) * MODW)
        if (IN_PH()) { PH_BEGIN(); asm volatile("; MARK3" ::: "memory");
            pg8::Gemm g{WSB(WS_XM), WL() + (second ? W_2IN : W_1IN) / 2, mrows, 2 * DFF, DM}; pg8::StaticOrder S; S.init(mrows, 2 * DFF, F.G, F.bid);
            pg8::EpiSwiGLU E{WSB(WS_H), DFF};
            pg8::gemm_phase<pg8::EpiSwiGLU, pg8::StaticOrder, true, true>(F.lds + RING_OFF, g, S, E, F.tid);
        } SEAM();
        if (IN_PH()) { PH_BEGIN(); asm volatile("; MARK4" ::: "memory");
            pg8::Gemm g{WSB(WS_H), WL() + (second ? W_2OUT : W_1OUT) / 2, mrows, DM, DFF}; pg8::StaticOrder S; S.init(mrows, DM, F.G, F.bid);
            const int gi = second ? 8 : 2;
            pg8::EpiRes E{WSF(WS_X), DM, MOD_LAT() + gi * DM, MOD_CTX() + gi * DM, 0.5f, ALPHA, SEQ / 256};
            pg8::gemm_phase<pg8::EpiRes, pg8::StaticOrder, true, true>(F.lds + RING_OFF, g, S, E, F.tid);
        } SEAM();
        if (IN_PH()) { PH_BEGIN(); asm volatile("; MARK5" ::: "memory");
            const int lni = second ? 2 : 0;
            const float* g = A.in[6] + (size_t)(l * 3 + lni) * DM; const float* b = A.in[7] + (size_t)(l * 3 + lni) * DM;
            const bool fin = second && last;
            const int lm = (second && !last) ? l + 1 : l;
            ln_pass(F, A, g, b, WSF(WS_MOD) + (size_t)(lm * 2) * MODW, WSF(WS_MOD) + (size_t)(lm * 2 + 1) * MODW, second ? 0 : 3, second ? 1 : 4, mrows, fin ? A.out : nullptr);
        } SEAM();
        if (!second) {
            if (IN_PH()) { PH_BEGIN(); asm volatile("; MARK6" ::: "memory");
                pg8::Gemm g{WSB(WS_XM), WL() + W_MI / 2, MTOT, DPROJ, DM}; pg8::StaticOrder S; S.init(MTOT, DPROJ, F.G, F.bid);
                pg8::EpiProj E{WSB(WS_PROJ), DPROJ, WSF(WS_ROPE), WSF(WS_ROPE) + 4096, WSF(WS_ROPE) + 8192, WSF(WS_ROPE) + 9216, SEQ, QS};
                pg8::gemm_phase<pg8::EpiProj, pg8::StaticOrder, true, true>(F.lds + RING_OFF, g, S, E, F.tid);
            } SEAM();
            if (IN_PH()) { PH_BEGIN(); asm volatile("; MARK7" ::: "memory");
                const int n_lat = 512 * 3 + 128, n_all = last ? n_lat : n_lat + 26;
                for (int u = F.bid; u < n_all; u += F.G) { PH_BEGIN();
                    int mode, ui; bool cx = false;
                    if (u < 512) { mode = 0; ui = u; } else if (u < 1024) { mode = 1; ui = u - 512; } else if (u < 1536) { mode = 2; ui = u - 1024; } else if (u < 1664) { mode = 3; ui = u - 1536; }
                    else if (u < 1672) { mode = 0; ui = u - 1664; cx = true; } else if (u < 1680) { mode = 1; ui = u - 1672; cx = true; } else if (u < 1688) { mode = 2; ui = u - 1680; cx = true; } else { mode = 3; ui = 128 + (u - 1688); }
                    if (mode == 0) attn_unit<0>(F, A, ui, cx, l);
                    else if (mode == 1) attn_unit<1>(F, A, ui, cx, l);
                    else if (mode == 2) attn_unit<2>(F, A, ui, cx, l);
                    else bmix_unit(F, A, ui, l);
                }
            } SEAM();
            { const int mr2 = last ? SEQ : MTOT;
            if (IN_PH()) { PH_BEGIN(); asm volatile("; MARK8" ::: "memory");
                pg8::Gemm g{WSB(WS_YCAT), WL() + W_MO / 2, mr2, DM, DM}; pg8::StaticOrder S; S.init(mr2, DM, F.G, F.bid);
                pg8::EpiRes E{WSF(WS_X), DM, MOD_LAT() + 5 * DM, MOD_CTX() + 5 * DM, 1.0f, ALPHA, SEQ / 256};
                pg8::gemm_phase<pg8::EpiRes, pg8::StaticOrder, true, true>(F.lds + RING_OFF, g, S, E, F.tid);
            } SEAM();
            if (IN_PH()) { PH_BEGIN(); asm volatile("; MARK9" ::: "memory");
                const float* g = A.in[6] + (size_t)(l * 3 + 1) * DM; const float* b = A.in[7] + (size_t)(l * 3 + 1) * DM;
                ln_pass(F, A, g, b, MOD_LAT(), MOD_CTX(), 6, 7, mr2, nullptr);
            } SEAM(); }
        }
    }
#undef IN_PH
#undef SEAM
}

extern "C" void kernel_launch(void* const* d_in, const int* in_sizes, int n_in, void* d_out, int out_size, void* d_ws, size_t ws_size, hipStream_t stream) {
    static int grid = 0;
    if (grid == 0) {
        if (n_in != 21 || in_sizes[0] != SEQ * DM || out_size != SEQ * DM || ws_size < WS_END) { fprintf(stderr, "kernel_launch: unexpected shapes (n_in %d, in0 %d, out %d, ws %zu); nothing launched\n", n_in, n_in > 0 ? in_sizes[0] : -1, out_size, ws_size); grid = -1; return; }
        int dev = 0, cus = 0, per_cu = 0;
        if (hipGetDevice(&dev) != hipSuccess || hipDeviceGetAttribute(&cus, hipDeviceAttributeMultiprocessorCount, dev) != hipSuccess) { grid = -1; return; }
        if (hipFuncSetAttribute((const void*)mega_fwd, hipFuncAttributeMaxDynamicSharedMemorySize, LDS_BYTES) != hipSuccess) { fprintf(stderr, "kernel_launch: hipFuncSetAttribute failed\n"); grid = -1; return; }
        if (hipOccupancyMaxActiveBlocksPerMultiprocessor(&per_cu, (const void*)mega_fwd, NTHREADS, LDS_BYTES) != hipSuccess || per_cu < 1) fprintf(stderr, "kernel_launch: occupancy query reports %d\n", per_cu);
        (void)hipGetLastError();
        grid = cus;
    }
    if (grid < 0) return;
    if (hipMemsetAsync((char*)d_ws + WS_CTL, 0, CTL_ZERO_BYTES, stream) != hipSuccess) return;
    Args a{};
    for (int i = 0; i < 21; ++i) a.in[i] = (const float*)d_in[i];
    a.out = (float*)d_out; a.ws = (unsigned char*)d_ws;
#if MK_SINGLE
    a.ph_lo = 0; a.ph_hi = N_PHASES;
    hipLaunchKernelGGL(mega_fwd, dim3(grid), dim3(NTHREADS), LDS_BYTES, stream, a);
#else
    for (int p = 0; p < N_PHASES; ++p) { a.ph_lo = p; a.ph_hi = p + 1; hipLaunchKernelGGL(mega_fwd, dim3(grid), dim3(NTHREADS), LDS_BYTES, stream, a); }
#endif
}
```

```cpp
#include <hip/hip_runtime.h>
#include <hip/hip_bf16.h>
#include <cstdio>
#include <cstdint>
#include <cmath>
namespace pg8 {
#define PG8_LAS __attribute__((address_space(3)))
typedef unsigned short bf16_t;
typedef short bf16x8 __attribute__((ext_vector_type(8)));
typedef float f32x4 __attribute__((ext_vector_type(4)));
typedef unsigned u32x4 __attribute__((ext_vector_type(4)));
constexpr int BM = 256, BK = 64, HALF = 128, HTB = HALF * BK * 2  , STAGE_BYTES = 8 * HTB, NXCD = 8, WGM = 8;

__host__ __device__ __forceinline__ int lds_byte(int r, int c) { const int st = (r >> 4) * 2 + (c >> 5), rr = r & 15, cc = c & 31, ob = rr * 64 + cc * 2; return st * 1024 + (ob ^ (((ob >> 9) & 1) << 5)); }
__host__ __device__ __forceinline__ void stage_rc(int b, int& R, int& C) { const int st = b / 1024, sb = b % 1024, swz = sb ^ (((sb >> 9) & 1) << 5); R = (st >> 1) * 16 + swz / 64; C = (st & 1) * 32 + (swz % 64) / 2; }
__host__ __device__ __forceinline__ int perm32(int rho) { const int n = rho >> 4, i = rho & 15; return 8 * (i >> 2) + 4 * n + (i & 3); }

struct Unit { int pm, pn; };
struct Gemm { const bf16_t* A; const bf16_t* Bt; int M, N, K; };

struct StaticOrder {
    int nM, nN, nwg, G, c;
    __host__ __device__ void init(int M, int N, int G_, int c_) { nM = M / BM; nN = N / BM; nwg = nM * nN; G = G_; c = c_; }
    __host__ __device__ bool next(int i, Unit& u) const {
        const long L = (long)i * G + c; if (L >= nwg) return false;
        int wgid = (int)L; { const int q = nwg / NXCD, r = nwg % NXCD, xcd = wgid % NXCD, off = wgid / NXCD; wgid = (xcd < r ? xcd * (q + 1) : r * (q + 1) + (xcd - r) * q) + off; }
        const int nig = WGM * nN, gid = wgid / nig, fm = gid * WGM, gsz = (nM - fm) < WGM ? (nM - fm) : WGM;
        u.pm = fm + ((wgid % nig) % gsz); u.pn = (wgid % nig) / gsz; return true;
    }
    __device__ __forceinline__ void a_ready(const Unit&) const {}
    __device__ __forceinline__ void done(const Unit&) const {}
};

__device__ __forceinline__ unsigned cvt_pk_bf16(float lo, float hi) { unsigned r; asm volatile("v_cvt_pk_bf16_f32 %0, %1, %2" : "=v"(r) : "v"(lo), "v"(hi)); return r; }
typedef float f32x2 __attribute__((ext_vector_type(2)));
__device__ __forceinline__ float silu_f(float x) { return x * __builtin_amdgcn_rcpf(1.0f + __builtin_amdgcn_exp2f(-1.4426950408889634f * x)); }
__device__ __forceinline__ float gelu_tanh_f(float x) { const float z2 = -2.0f * 1.4426950408889634f * 0.7978845608028654f * (x + 0.044715f * x * x * x); return x * __builtin_amdgcn_rcpf(1.0f + __builtin_amdgcn_exp2f(z2)); }

struct EpiSwiGLU {
    static constexpr bool PERM = true, AFTER_DRAIN = false;
    bf16_t* H; int ldh;
    __device__ __forceinline__ void operator()(const f32x4 (&acc)[2][2][4][2], const Unit& u, int wr, int wc, int fr, int fq) const {
        const int row0 = u.pm * BM + wr * 64 + fr, col0 = u.pn * HALF + wc * 32 + 8 * fq;
#pragma unroll
        for (int ai = 0; ai < 2; ++ai)
#pragma unroll
            for (int m = 0; m < 4; ++m) { bf16_t* rowp = H + (size_t)(row0 + ai * HALF + m * 16) * ldh + col0;
                const f32x4 g0 = acc[ai][0][m][0], g1 = acc[ai][0][m][1], u0 = acc[ai][1][m][0], u1 = acc[ai][1][m][1];
                u32x4 w;
                w.x = cvt_pk_bf16(silu_f(g0[0]) * u0[0], silu_f(g0[1]) * u0[1]); w.y = cvt_pk_bf16(silu_f(g0[2]) * u0[2], silu_f(g0[3]) * u0[3]);
                w.z = cvt_pk_bf16(silu_f(g1[0]) * u1[0], silu_f(g1[1]) * u1[1]); w.w = cvt_pk_bf16(silu_f(g1[2]) * u1[2], silu_f(g1[3]) * u1[3]);
                *(u32x4*)rowp = w; }
    }
};

struct EpiRes {
    static constexpr bool PERM = false, AFTER_DRAIN = false;
    float* X; int ldx; const float* gate_lat; const float* gate_ctx; float gscale, alpha; int ctx_pm;
    __device__ __forceinline__ void operator()(const f32x4 (&acc)[2][2][4][2], const Unit& u, int wr, int wc, int fr, int fq) const {
        const float* gp = (u.pm >= ctx_pm) ? gate_ctx : gate_lat;
        const int col0 = u.pn * BM + wc * 32 + 4 * fq;
        f32x4 gv[2][2];
#pragma unroll
        for (int bj = 0; bj < 2; ++bj)
#pragma unroll
            for (int n = 0; n < 2; ++n) gv[bj][n] = *(const f32x4*)(gp + col0 + bj * HALF + n * 16) * gscale;
#pragma unroll
        for (int ai = 0; ai < 2; ++ai)
#pragma unroll
            for (int m = 0; m < 4; ++m) { float* xp = X + (size_t)(u.pm * BM + ai * HALF + wr * 64 + m * 16 + fr) * ldx + col0;
#pragma unroll
                for (int bj = 0; bj < 2; ++bj)
#pragma unroll
                    for (int n = 0; n < 2; ++n) { f32x4 x = *(const f32x4*)(xp + bj * HALF + n * 16); x = x * alpha + gv[bj][n] * acc[ai][bj][m][n]; *(f32x4*)(xp + bj * HALF + n * 16) = x; } }
    }
};

struct EpiProj {
    static constexpr bool PERM = true, AFTER_DRAIN = false;
    bf16_t* P; int ldp; const float* cosR; const float* sinR; const float* cosC; const float* sinC; int seq; float qs;
    __device__ __forceinline__ void operator()(const f32x4 (&acc)[2][2][4][2], const Unit& u, int wr, int wc, int fr, int fq) const {
        const int row0 = u.pm * BM + wr * 64 + fr;
#pragma unroll
        for (int bj = 0; bj < 2; ++bj) {
            const int hc = u.pn * BM + bj * HALF;
            int mode = 0; float sc = 1.0f;
            if (hc < 512) { mode = 1; sc = qs; } else if (hc < 1024) { mode = 1; } else if (hc < 1536) { mode = 0; } else if (hc < 2560) { mode = 2; }
            else if (hc < 3072) { mode = 1; sc = qs; } else if (hc < 3200) { mode = 1; } else if (hc < 3328) { mode = 0; } else if (hc < 3840) { mode = 0; sc = qs; }
            const float* ct = (wc & 1) ? cosC : cosR; const float* st = (wc & 1) ? sinC : sinR;
#pragma unroll
            for (int ai = 0; ai < 2; ++ai)
#pragma unroll
                for (int m = 0; m < 4; ++m) { const int row = row0 + ai * HALF + m * 16;
                    f32x4 v0 = acc[ai][bj][m][0], v1 = acc[ai][bj][m][1];
                    if (mode == 1) { if (row < seq) { const int pos = (wc & 1) ? (row & 63) : (row >> 6);
                            const f32x4 c = *(const f32x4*)(ct + pos * 16 + 4 * fq), s = *(const f32x4*)(st + pos * 16 + 4 * fq);
                            const f32x4 o0 = v0 * c - v1 * s, o1 = v0 * s + v1 * c; v0 = o0; v1 = o1; } }
                    else if (mode == 2) { v0 = (f32x4){gelu_tanh_f(v0[0]), gelu_tanh_f(v0[1]), gelu_tanh_f(v0[2]), gelu_tanh_f(v0[3])}; v1 = (f32x4){gelu_tanh_f(v1[0]), gelu_tanh_f(v1[1]), gelu_tanh_f(v1[2]), gelu_tanh_f(v1[3])}; }
                    v0 = v0 * sc; v1 = v1 * sc;
                    u32x4 w; w.x = cvt_pk_bf16(v0[0], v0[1]); w.y = cvt_pk_bf16(v0[2], v0[3]); w.z = cvt_pk_bf16(v1[0], v1[1]); w.w = cvt_pk_bf16(v1[2], v1[3]);
                    *(u32x4*)(P + (size_t)row * ldp + hc + wc * 32 + 8 * fq) = w; }
        }
    }
};
template <class Epi, class Sched, bool ALIGN_EPI = false, bool SP2 = false>
__device__ __forceinline__ void gemm_phase(PG8_LAS unsigned char* lds, const Gemm g, const Sched& S, const Epi& E, const int tid) {
    const int wid = __builtin_amdgcn_readfirstlane(tid >> 6), lane = tid & 63, wr = wid >> 2, wc = wid & 3, fr = lane & 15, fq = lane >> 4;
    const int K = g.K, nt = K / BK;
    unsigned voffA[2], voffB[2];
#pragma unroll
    for (int i = 0; i < 2; ++i) { int R, C; stage_rc(tid * 16 + i * 8192, R, C); const int Rb = Epi::PERM ? ((R & ~31) + perm32(R & 31)) : R;
        voffA[i] = (unsigned)(R * K + C) * 2u; voffB[i] = (unsigned)(Rb * K + C) * 2u; }
    const size_t kstep = (size_t)(BK * 2);
    const size_t hstep = (size_t)HALF * K * 2;
    const size_t tstep = 2 * hstep;
    const unsigned ldsw = (unsigned)wid * 1024u;
    const int aoff = lds_byte(wr * 64 + fr, fq * 8), boff = lds_byte(wc * 32 + fr, fq * 8);
#define PG8_SA(b, h) (((b) * 2 + (h)) * HTB)
#define PG8_SB(b, h) ((4 + (b) * 2 + (h)) * HTB)
#define PG8_STAGE(bufoff, gbase, voff) do { _Pragma("unroll") for (int _i = 0; _i < 2; ++_i) \
        __builtin_amdgcn_global_load_lds((const unsigned*)((const char*)(gbase) + (voff)[_i]), (PG8_LAS unsigned*)(lds + (bufoff) + ldsw + _i * 8192), 16, 0, 0); } while (0)
#define PG8_LDA(dst, b, h) do { _Pragma("unroll") for (int m = 0; m < 4; ++m) _Pragma("unroll") for (int k = 0; k < 2; ++k) dst[m][k] = *(const PG8_LAS bf16x8*)(lds + PG8_SA(b, h) + aoff + m * 2048 + k * 1024); } while (0)
#define PG8_LDB(dst, b, h) do { _Pragma("unroll") for (int n = 0; n < 2; ++n) _Pragma("unroll") for (int k = 0; k < 2; ++k) dst[n][k] = *(const PG8_LAS bf16x8*)(lds + PG8_SB(b, h) + boff + n * 2048 + k * 1024); } while (0)
#define PG8_MMA(ai, bj, At, Bt) do { __builtin_amdgcn_s_setprio(1); _Pragma("unroll") for (int m = 0; m < 4; ++m) _Pragma("unroll") for (int n = 0; n < 2; ++n) _Pragma("unroll") for (int k = 0; k < 2; ++k) \
        acc[ai][bj][m][n] = __builtin_amdgcn_mfma_f32_16x16x32_bf16(Bt[n][k], At[m][k], acc[ai][bj][m][n], 0, 0, 0); __builtin_amdgcn_s_setprio(0); } while (0)
#define PG8_WAIT_V(n) asm volatile("s_waitcnt vmcnt(" #n ")" ::: "memory")
#define PG8_WAIT_L(n) asm volatile("s_waitcnt lgkmcnt(" #n ")" ::: "memory")
#define PG8_BAR __builtin_amdgcn_s_barrier()
#define PG8_SCHED __builtin_amdgcn_sched_barrier(0)
    Unit cur, nxt; int ui = 0;
    if (!S.next(0, cur)) return;
    f32x4 acc[2][2][4][2];
#pragma unroll
    for (int a = 0; a < 2; ++a)
#pragma unroll
        for (int b = 0; b < 2; ++b)
#pragma unroll
            for (int m = 0; m < 4; ++m)
#pragma unroll
                for (int n = 0; n < 2; ++n) acc[a][b][m][n] = (f32x4){0.f, 0.f, 0.f, 0.f};
    bf16x8 At[4][2], B0[2][2], B1[2][2];
    const char* cA = (const char*)g.A + (size_t)cur.pm * tstep; const char* cB = (const char*)g.Bt + (size_t)cur.pn * tstep;
    S.a_ready(cur);
    if constexpr (SP2) {
        PG8_STAGE(PG8_SB(0, 0), cB, voffB); PG8_STAGE(PG8_SB(0, 1), cB + hstep, voffB); PG8_STAGE(PG8_SA(0, 0), cA, voffA); PG8_STAGE(PG8_SA(0, 1), cA + hstep, voffA);
        if (wr == 1) PG8_BAR;
        PG8_WAIT_V(2); PG8_BAR;
        PG8_STAGE(PG8_SB(1, 0), cB + kstep, voffB); PG8_STAGE(PG8_SA(1, 0), cA + kstep, voffA); PG8_STAGE(PG8_SB(1, 1), cB + hstep + kstep, voffB);
        PG8_WAIT_V(6); PG8_BAR;
    } else {
        PG8_STAGE(PG8_SB(0, 0), cB, voffB); PG8_STAGE(PG8_SA(0, 0), cA, voffA); PG8_STAGE(PG8_SB(0, 1), cB + hstep, voffB); PG8_STAGE(PG8_SA(0, 1), cA + hstep, voffA);
        if (wr == 1) PG8_BAR;
        PG8_WAIT_V(4); PG8_BAR;
        PG8_STAGE(PG8_SB(1, 0), cB + kstep, voffB); PG8_STAGE(PG8_SA(1, 0), cA + kstep, voffA); PG8_STAGE(PG8_SB(1, 1), cB + hstep + kstep, voffB);
        PG8_WAIT_V(6); PG8_BAR;
    }
    for (;;) {
        const bool has_next = S.next(ui + 1, nxt);
        const char* nA = has_next ? (const char*)g.A + (size_t)nxt.pm * tstep : cA; const char* nB = has_next ? (const char*)g.Bt + (size_t)nxt.pn * tstep : cB;
        for (int t = 0; t < nt; t += 2) {
            const bool last = (t == nt - 2);
            const char* a1 = cA + (size_t)(t + 1) * kstep;
            const char* a2 = last ? nA : cA + (size_t)(t + 2) * kstep; const char* b2 = last ? nB : cB + (size_t)(t + 2) * kstep;
            const char* a3 = a2 + kstep; const char* b3 = b2 + kstep;
            if (last && has_next) S.a_ready(nxt);
            if constexpr (SP2) {
            PG8_LDB(B0, 0, 0); PG8_LDB(B1, 0, 1); PG8_SCHED; PG8_LDA(At, 0, 0); PG8_STAGE(PG8_SA(1, 1), a1 + hstep, voffA);
            PG8_WAIT_V(8); PG8_WAIT_L(0); PG8_BAR; PG8_MMA(0, 0, At, B0); PG8_MMA(0, 1, At, B1); PG8_BAR; PG8_SCHED;
            PG8_LDA(At, 0, 1); PG8_STAGE(PG8_SB(0, 0), b2, voffB); PG8_STAGE(PG8_SB(0, 1), b2 + hstep, voffB); PG8_STAGE(PG8_SA(0, 0), a2, voffA);
            PG8_WAIT_V(8); PG8_WAIT_L(0); PG8_BAR; PG8_MMA(1, 0, At, B0); PG8_MMA(1, 1, At, B1); PG8_BAR; PG8_SCHED;
            PG8_LDB(B0, 1, 0); PG8_LDB(B1, 1, 1); PG8_SCHED; PG8_LDA(At, 1, 0); PG8_STAGE(PG8_SA(0, 1), a2 + hstep, voffA);
            PG8_WAIT_V(8); PG8_WAIT_L(0); PG8_BAR; PG8_MMA(0, 0, At, B0); PG8_MMA(0, 1, At, B1); PG8_BAR; PG8_SCHED;
            PG8_LDA(At, 1, 1); PG8_STAGE(PG8_SB(1, 0), b3, voffB); PG8_STAGE(PG8_SB(1, 1), b3 + hstep, voffB); PG8_STAGE(PG8_SA(1, 0), a3, voffA);
            PG8_WAIT_V(8); PG8_WAIT_L(0); PG8_BAR; PG8_MMA(1, 0, At, B0); PG8_MMA(1, 1, At, B1); PG8_BAR; PG8_SCHED;
            } else {
            PG8_LDB(B0, 0, 0); PG8_SCHED; PG8_LDA(At, 0, 0); PG8_STAGE(PG8_SA(1, 1), a1 + hstep, voffA);
            PG8_WAIT_L(8); PG8_BAR; PG8_WAIT_L(0); PG8_MMA(0, 0, At, B0); PG8_BAR; PG8_SCHED;
            PG8_LDB(B1, 0, 1); PG8_STAGE(PG8_SB(0, 0), b2, voffB);
            PG8_BAR; PG8_WAIT_L(0); PG8_MMA(0, 1, At, B1); PG8_BAR;
            PG8_LDA(At, 0, 1); PG8_STAGE(PG8_SA(0, 0), a2, voffA);
            PG8_BAR; PG8_WAIT_L(0); PG8_MMA(1, 0, At, B0); PG8_BAR; PG8_SCHED;
            PG8_STAGE(PG8_SB(0, 1), b2 + hstep, voffB);
            PG8_WAIT_V(6); PG8_BAR; PG8_MMA(1, 1, At, B1); PG8_BAR;
            PG8_LDB(B0, 1, 0); PG8_SCHED; PG8_LDA(At, 1, 0); PG8_STAGE(PG8_SA(0, 1), a2 + hstep, voffA);
            PG8_WAIT_L(8); PG8_BAR; PG8_WAIT_L(0); PG8_MMA(0, 0, At, B0); PG8_BAR; PG8_SCHED;
            PG8_LDB(B1, 1, 1); PG8_STAGE(PG8_SB(1, 0), b3, voffB);
            PG8_BAR; PG8_WAIT_L(0); PG8_MMA(0, 1, At, B1); PG8_BAR;
            PG8_LDA(At, 1, 1); PG8_STAGE(PG8_SA(1, 0), a3, voffA);
            PG8_BAR; PG8_WAIT_L(0); PG8_MMA(1, 0, At, B0); PG8_BAR; PG8_SCHED;
            PG8_STAGE(PG8_SB(1, 1), b3 + hstep, voffB);
            PG8_WAIT_V(6); PG8_BAR; PG8_MMA(1, 1, At, B1); PG8_BAR;
            }
        }
        if constexpr (ALIGN_EPI) { if (wr == 0) PG8_BAR; }
        if constexpr (!Epi::AFTER_DRAIN) { E(acc, cur, wr, wc, fr, fq); S.done(cur); }
        if (!has_next) break;
#pragma unroll
        for (int a = 0; a < 2; ++a)
#pragma unroll
            for (int b = 0; b < 2; ++b)
#pragma unroll
                for (int m = 0; m < 4; ++m)
#pragma unroll
                    for (int n = 0; n < 2; ++n) acc[a][b][m][n] = (f32x4){0.f, 0.f, 0.f, 0.f};
        cur = nxt; cA = nA; cB = nB; ++ui;
        if constexpr (ALIGN_EPI) { if (wr == 1) PG8_BAR; }
    }
    PG8_WAIT_V(0);
    if constexpr (!ALIGN_EPI) { if (wr == 0) PG8_BAR; }
    PG8_BAR;
    if constexpr (Epi::AFTER_DRAIN) { E.fused(acc, cur, wr, wc, fr, fq, lds, wid, lane); S.done(cur); }
#undef PG8_SA
#undef PG8_SB
#undef PG8_STAGE
#undef PG8_LDA
#undef PG8_LDB
#undef PG8_MMA
#undef PG8_WAIT_V
#undef PG8_WAIT_L
#undef PG8_BAR
#undef PG8_SCHED
}
}
#define GAS __attribute__((address_space(1)))
#define LAS __attribute__((address_space(3)))
typedef unsigned short bf16;
typedef unsigned v4u __attribute__((ext_vector_type(4)));
typedef float f32x4 __attribute__((ext_vector_type(4)));
typedef short bf16x8 __attribute__((ext_vector_type(8)));
typedef GAS unsigned gu32;
typedef GAS unsigned long long gu64;
#define RLX_AGENT __ATOMIC_RELAXED, __HIP_MEMORY_SCOPE_AGENT
#define LDS_WAIT() asm volatile("s_waitcnt lgkmcnt(0)" ::: "memory")
#define VM_WAIT() asm volatile("s_waitcnt vmcnt(0)" ::: "memory")
__device__ __forceinline__ unsigned long long rt() { return __builtin_amdgcn_s_memrealtime(); }
__device__ __forceinline__ unsigned f2bf(float f) { unsigned u = __builtin_bit_cast(unsigned, f); return (u + 0x7fffu + ((u >> 16) & 1u)) >> 16; }
__device__ __forceinline__ unsigned pk2(float lo, float hi) { return f2bf(lo) | (f2bf(hi) << 16); }

#define XB_TMO      128
#define XB_XCNT(j)  (256  + 64 * (j))
#define XB_XSUB(j)  (1280 + 64 * (j))
#define XB_XGEN(j)  (2304 + 64 * (j))
#define XB_TOP      3328
#define XB_TOPGEN   3392
#define XCD_BAR_WORDS 3456
#define XB_SPIN_CAP (1u << 18)

__device__ __forceinline__ unsigned xb_ld(unsigned* p)              { return __hip_atomic_load(p, __ATOMIC_RELAXED, __HIP_MEMORY_SCOPE_AGENT); }
__device__ __forceinline__ unsigned xb_add(unsigned* p, unsigned v) { return __hip_atomic_fetch_add(p, v, __ATOMIC_RELAXED, __HIP_MEMORY_SCOPE_AGENT); }
__device__ __forceinline__ unsigned xb_xcc_id() { return (unsigned)__builtin_amdgcn_s_getreg((3 << 11) | 20) & 0xFu; }
#define XB_SPIN(cond, bar) do { unsigned _sp = 0; while (cond) { __builtin_amdgcn_s_sleep(1); \
    if ((++_sp & 255u) == 0u) { if (xb_ld(&(bar)[XB_TMO])) break; if (_sp > XB_SPIN_CAP) { atomicAdd(&(bar)[XB_TMO], 1u); break; } } } } while (0)

struct XcdBarrier {
    unsigned* bar; unsigned x;
    volatile LAS unsigned* st;
};

__device__ __forceinline__ XcdBarrier xcd_barrier_post(unsigned* bar, volatile LAS unsigned* st) {
    XcdBarrier b; b.bar = bar; b.x = xb_xcc_id(); b.st = st;
    if (threadIdx.x == 0) (void)xb_add(&bar[XB_XCNT(b.x)], 1u);
    return b;
}
__device__ __forceinline__ void xcd_barrier_complete(unsigned* bar, unsigned x, unsigned& nloc, unsigned& nx) {
    const unsigned G = gridDim.x * gridDim.y * gridDim.z;
    unsigned sum, cnt, mine, sp = 0u;
    for (;;) {
        sum = 0u; cnt = 0u; mine = 0u;
#pragma unroll
        for (unsigned j = 0; j < 16; ++j) { const unsigned c = xb_ld(&bar[XB_XCNT(j)]); sum += c; cnt += (c > 0u) ? 1u : 0u; mine = (j == x) ? c : mine; }
        if (sum == G) break;
        __builtin_amdgcn_s_sleep(1);
        if ((++sp & 255u) == 0u) { if (xb_ld(&bar[XB_TMO])) break; if (sp > XB_SPIN_CAP) { atomicAdd(&bar[XB_TMO], 1u); break; } }
    }
    nloc = mine > 0u ? mine : 1u; nx = cnt > 0u ? cnt : 1u;
}

__device__ __forceinline__ void xcd_barrier(const XcdBarrier& b) {
    asm volatile("s_waitcnt vmcnt(0)" ::: "memory");
    __syncthreads();
    if (threadIdx.x == 0) {
        unsigned* bar = b.bar;
        __builtin_amdgcn_s_waitcnt(0);
        unsigned nloc = b.st[0], nx = b.st[1];
        if (nloc == 0u) { xcd_barrier_complete(bar, b.x, nloc, nx); b.st[0] = nloc; b.st[1] = nx; }
        const unsigned old = xb_add(&bar[XB_XSUB(b.x)], 1u);
        const unsigned gen = old / nloc;
        if (old + 1u == (gen + 1u) * nloc) {
            __builtin_amdgcn_fence(__ATOMIC_RELEASE, "agent");
            asm volatile("s_waitcnt vmcnt(0)" ::: "memory");
            const unsigned og = xb_add(&bar[XB_TOP], 1u);
            const unsigned tg = og / nx;
            if (og + 1u == (tg + 1u) * nx) xb_add(&bar[XB_TOPGEN], 1u);
            else XB_SPIN(xb_ld(&bar[XB_TOPGEN]) == tg, bar);
            __builtin_amdgcn_fence(__ATOMIC_ACQUIRE, "agent");
            xb_add(&bar[XB_XGEN(b.x)], 1u);
            asm volatile("s_waitcnt vmcnt(0)" ::: "memory");
        } else {
            XB_SPIN(xb_ld(&bar[XB_XGEN(b.x)]) == gen, bar);
            __builtin_amdgcn_fence(__ATOMIC_ACQUIRE, "agent");
            asm volatile("s_waitcnt vmcnt(0)" ::: "memory");
        }
    }
    __syncthreads();
}

constexpr int DM = 2048, SEQ = 16384, CTXL = 256, MTOT = SEQ + CTXL, NLAYER = 4, DFF = 5632, DPROJ = 4864, NMOD = 9, MODW = NMOD * DM;
constexpr int NWAVES = 8, NTHREADS = NWAVES * 64;
constexpr float LN_EPS = 1e-6f, ALPHA = 1.681792830507429f, LOG2E = 1.4426950408889634f, QS = 0.125f * LOG2E;
constexpr int C_AQ = 0, C_AK = 512, C_AV = 1024, C_BU = 1536, C_BV = 2048, C_CQ = 2560, C_CK = 3072, C_CV = 3200, C_DQ = 3328, C_DK = 3840, C_DV = 4352;

constexpr size_t MiB = 1u << 20;
constexpr size_t WS_CTL = 0, CTL_ZERO_BYTES = 1 * MiB;
constexpr size_t WS_MOD = 1 * MiB;
constexpr size_t WS_LAM = WS_MOD + 640 * 1024;
constexpr size_t WS_ROPE = WS_MOD + 704 * 1024;
constexpr size_t WS_WSP = 3 * MiB;
constexpr size_t WS_W = 4 * MiB;
constexpr size_t W_1IN = 0, W_1OUT = 44 * MiB, W_2IN = 66 * MiB, W_2OUT = 110 * MiB, W_MI = 132 * MiB, W_MO = 151 * MiB, W_LAYER = 159 * MiB;
constexpr size_t WS_X = 640 * MiB;
constexpr size_t WS_XM = 770 * MiB;
constexpr size_t WS_H = 835 * MiB;
constexpr size_t WS_PROJ = 1014 * MiB;
constexpr size_t WS_YCAT = 1169 * MiB;
constexpr size_t WS_END = 1234 * MiB;
static_assert(WS_W + NLAYER * W_LAYER <= WS_X && WS_X + (size_t)MTOT * DM * 4 <= WS_XM && WS_XM + (size_t)MTOT * DM * 2 <= WS_H && WS_H + (size_t)MTOT * DFF * 2 <= WS_PROJ &&
              WS_PROJ + (size_t)MTOT * DPROJ * 2 <= WS_YCAT && WS_YCAT + (size_t)MTOT * DM * 2 <= WS_END, "d_ws map");
constexpr int CW_TMO = 0, CW_BAR = 4096;
constexpr int RING_OFF = 0, RING_BYTES = 131072;
constexpr int LDSCTL_OFF = RING_BYTES, MISC_OFF = LDSCTL_OFF + 320;
constexpr int LDS_BYTES = 147456;

struct Args { const float* in[21]; float* out; unsigned char* ws; int ph_lo, ph_hi; };
struct Frame {
    LAS unsigned char* lds;
    unsigned char* ws;
    int tid, lane, wave, G, gw, ngw, bid;
};
__device__ __forceinline__ float wave_sum(float v) {
#pragma unroll
    for (int o = 1; o < 64; o <<= 1) v += __shfl_xor(v, o);
    return v;
}
__device__ __forceinline__ unsigned cvt2(float lo, float hi) { typedef float f2 __attribute__((ext_vector_type(2))); typedef __bf16 b2 __attribute__((ext_vector_type(2))); f2 v = {lo, hi}; b2 b = __builtin_convertvector(v, b2); return __builtin_bit_cast(unsigned, b); }
__device__ __forceinline__ float bf_lo(unsigned w) { return __uint_as_float(w << 16); }
__device__ __forceinline__ float bf_hi(unsigned w) { return __uint_as_float(w & 0xffff0000u); }

__device__ const float ROPE_INV[16] = {1.000000000e+00f, 5.623413324e-01f, 3.162277639e-01f, 1.778279394e-01f, 1.000000015e-01f, 5.623413250e-02f, 3.162277490e-02f, 1.778279431e-02f,
                                       9.999999776e-03f, 5.623413250e-03f, 3.162277630e-03f, 1.778279431e-03f, 1.000000047e-03f, 5.623413017e-04f, 3.162277571e-04f, 1.778279402e-04f};

__device__ __forceinline__ int map_dest(int mapk, int n) {
    if (mapk == 1) { const int s = n >= DFF ? 1 : 0, hid = n - s * DFF; return (hid >> 7) * 256 + s * 128 + (hid & 127); }
    if (mapk == 2) { const bool rope = (n < C_AV) || (n >= C_CQ && n < C_CV); if (rope) { const int d = n & 63; return (n & ~63) + 32 * ((d >> 4) & 1) + 8 * ((d >> 2) & 3) + 4 * (d >> 5) + (d & 3); } }
    return n;
}
__device__ __forceinline__ void transpose_item(const float* W, int K, int N, bf16* WT, int mapk, LAS float* scr, int item, int lane) {
    const int nblk = N / 32, kb = item / nblk, nb = item % nblk, k0 = 64 * kb, n0 = 32 * nb;
#pragma unroll 8
    for (int i = 0; i < 32; ++i) { const int kk = 2 * i + (lane >> 5); scr[kk * 33 + (lane & 31)] = W[(size_t)(k0 + kk) * N + n0 + (lane & 31)]; }
    LDS_WAIT(); asm volatile("" ::: "memory");
    const int c = lane & 7;
#pragma unroll
    for (int j = 0; j < 4; ++j) { const int n = (lane >> 3) + 8 * j; const LAS float* s = scr + (8 * c) * 33 + n;
        v4u o; o.x = pk2(s[0 * 33], s[1 * 33]); o.y = pk2(s[2 * 33], s[3 * 33]); o.z = pk2(s[4 * 33], s[5 * 33]); o.w = pk2(s[6 * 33], s[7 * 33]);
        *(GAS v4u*)(WT + (size_t)map_dest(mapk, n0 + n) * K + k0 + 8 * c) = o; }
    LDS_WAIT(); asm volatile("" ::: "memory");
}
__device__ __forceinline__ void sincos_acc(float ang, float& s, float& c) {
    const double x = (double)ang, k = __builtin_rint(x * 0.15915494309189535);
    const double y = (x - k * 6.283185307179586) - k * 2.4492935982947064e-16, y2 = y * y;
    double ts = y, ss = y, tc = 1.0, cs = 1.0;
    for (int n = 1; n <= 14; ++n) { tc *= -y2 / (double)((2 * n - 1) * (2 * n)); cs += tc; ts *= -y2 / (double)((2 * n) * (2 * n + 1)); ss += ts; }
    s = (float)ss; c = (float)cs;
}
__device__ __forceinline__ float silu_s(float x) { return x / (1.0f + __expf(-x)); }

__device__ __forceinline__ void p0a(Frame& F, const Args& A) {
    LAS float* sc = (LAS float*)(F.lds + RING_OFF); LAS float* scc = sc + DM; LAS float* red = sc + 2 * DM;
    for (int i = F.tid; i < DM; i += NTHREADS) { sc[i] = silu_s(A.in[1][i]); scc[i] = silu_s(A.in[3][i]); }
    __syncthreads();
    { const int cq = F.tid & 15, ks = F.tid >> 4;
      for (int it = F.bid; it < NLAYER * (MODW / 64); it += F.G) {
        const int l = it / (MODW / 64), jg = it % (MODW / 64);
        const float* Wl = A.in[4] + (size_t)l * DM * MODW + 64 * jg + 4 * cq + (size_t)(ks * 64) * MODW;
        f32x4 ax = {0.f, 0.f, 0.f, 0.f}, ac = {0.f, 0.f, 0.f, 0.f};
#pragma unroll 8
        for (int kk = 0; kk < 64; ++kk) { const f32x4 w = *(const GAS f32x4*)(Wl + (size_t)kk * MODW); ax += w * sc[ks * 64 + kk]; ac += w * scc[ks * 64 + kk]; }
        LAS float* rp = red + (ks * 16 + cq) * 8;
        rp[0] = ax[0]; rp[1] = ax[1]; rp[2] = ax[2]; rp[3] = ax[3]; rp[4] = ac[0]; rp[5] = ac[1]; rp[6] = ac[2]; rp[7] = ac[3];
        __syncthreads();
        if (F.tid < 128) { const int cq2 = F.tid & 15, comp = F.tid >> 4; float s = 0.f;
            for (int k2 = 0; k2 < 32; ++k2) s += red[(k2 * 16 + cq2) * 8 + comp];
            const int j = 64 * jg + 4 * cq2 + (comp & 3), ty = comp >> 2;
            ((float*)(F.ws + WS_MOD))[(size_t)(l * 2 + ty) * MODW + j] = s + A.in[5][(size_t)l * MODW + j]; }
        __syncthreads();
      } }
    { LAS float* scr = (LAS float*)(F.lds + RING_OFF + F.wave * 16384);
      constexpr int I_IN = (DM / 64) * (2 * DFF / 32), I_OUT = (DFF / 64) * (DM / 32), I_MI = (DM / 64) * (DPROJ / 32), I_MO = (DM / 64) * (DM / 32), I_L = 2 * I_IN + 2 * I_OUT + I_MI + I_MO;
      for (int it = F.gw; it < NLAYER * I_L; it += F.ngw) {
        const int l = it / I_L; int r = it % I_L; bf16* Wl = ((bf16*)(F.ws + WS_W)) + (size_t)l * (W_LAYER / 2);
        if (r < I_IN) { transpose_item(A.in[8] + (size_t)l * DM * 2 * DFF, DM, 2 * DFF, Wl + W_1IN / 2, 1, scr, r, F.lane); continue; } r -= I_IN;
        if (r < I_OUT) { transpose_item(A.in[9] + (size_t)l * DFF * DM, DFF, DM, Wl + W_1OUT / 2, 0, scr, r, F.lane); continue; } r -= I_OUT;
        if (r < I_IN) { transpose_item(A.in[10] + (size_t)l * DM * 2 * DFF, DM, 2 * DFF, Wl + W_2IN / 2, 1, scr, r, F.lane); continue; } r -= I_IN;
        if (r < I_OUT) { transpose_item(A.in[11] + (size_t)l * DFF * DM, DFF, DM, Wl + W_2OUT / 2, 0, scr, r, F.lane); continue; } r -= I_OUT;
        if (r < I_MI) { transpose_item(A.in[12] + (size_t)l * DM * DPROJ, DM, DPROJ, Wl + W_MI / 2, 2, scr, r, F.lane); continue; } r -= I_MI;
        transpose_item(A.in[13] + (size_t)l * DM * DM, DM, DM, Wl + W_MO / 2, 0, scr, r, F.lane);
      } }
    { const int gt = F.bid * NTHREADS + F.tid, ngt = F.G * NTHREADS;
      for (int e = gt; e < 320 * 16; e += ngt) { const int pos = e >> 4, f = e & 15; float s, c;
        if (pos < 256) { sincos_acc((float)pos * ROPE_INV[f], s, c); ((float*)(F.ws + WS_ROPE))[pos * 16 + f] = c; ((float*)(F.ws + WS_ROPE))[4096 + pos * 16 + f] = s; }
        else { const int p2 = pos - 256; sincos_acc((float)p2 * ROPE_INV[f], s, c); ((float*)(F.ws + WS_ROPE))[8192 + p2 * 16 + f] = c; ((float*)(F.ws + WS_ROPE))[9216 + p2 * 16 + f] = s; } }
      for (int e = gt; e < NLAYER * 4 * 128 * 128; e += ngt) ((bf16*)(F.ws + WS_WSP))[e] = (bf16)f2bf(A.in[17][e]);
      if (gt < NLAYER) { const float* lv = A.in[14] + gt * 256; float s01 = 0.f, s23 = 0.f;
        for (int i = 0; i < 64; ++i) { s01 += lv[i] * lv[64 + i]; s23 += lv[128 + i] * lv[192 + i]; }
        const float li = 0.8f - 0.6f * expf(-0.3f * (float)gt);
        ((float*)(F.ws + WS_LAM))[gt * 4 + 0] = expf(s01) - expf(s23) + li; ((float*)(F.ws + WS_LAM))[gt * 4 + 1] = 1.0f - li; } }
}
__device__ __forceinline__ void p0b(Frame& F, const Args& A) {
    for (int row = F.gw; row < MTOT; row += F.ngw) {
        const float* src = row < SEQ ? A.in[0] + (size_t)row * DM : A.in[2] + (size_t)(row - SEQ) * DM;
        const float* mod = ((float*)(F.ws + WS_MOD)) + (size_t)(row >= SEQ ? 1 : 0) * MODW;
#pragma unroll
        for (int j = 0; j < 8; ++j) { const int idx = (F.lane + 64 * j) * 4;
            const f32x4 v = *(const GAS f32x4*)(src + idx), sh = *(const GAS f32x4*)(mod + idx), sc = *(const GAS f32x4*)(mod + DM + idx);
            *(GAS f32x4*)(((float*)(F.ws + WS_X)) + (size_t)row * DM + idx) = v;
            const f32x4 o = v * (sc + 1.0f) + sh;
            *(GAS unsigned long long*)(((bf16*)(F.ws + WS_XM)) + (size_t)row * DM + idx) = (unsigned long long)cvt2(o[0], o[1]) | ((unsigned long long)cvt2(o[2], o[3]) << 32); }
    }
}
__device__ __forceinline__ void ln_pass(Frame& F, const Args& A, const float* g, const float* b, const float* mod_lat, const float* mod_ctx, int ish, int isc, int nrows, float* fin) {
    for (int row = F.gw; row < nrows; row += F.ngw) {
        float* xr = ((float*)(F.ws + WS_X)) + (size_t)row * DM; f32x4 v[8]; float s = 0.f;
#pragma unroll
        for (int j = 0; j < 8; ++j) { v[j] = *(const GAS f32x4*)(xr + (F.lane + 64 * j) * 4); s += (v[j][0] + v[j][1]) + (v[j][2] + v[j][3]); }
        const float mean = wave_sum(s) * (1.0f / DM); float s2 = 0.f;
#pragma unroll
        for (int j = 0; j < 8; ++j) { v[j] = v[j] - mean; s2 += (v[j][0] * v[j][0] + v[j][1] * v[j][1]) + (v[j][2] * v[j][2] + v[j][3] * v[j][3]); }
        const float rstd = 1.0f / sqrtf(wave_sum(s2) * (1.0f / DM) + LN_EPS);
        const float* mod = row >= SEQ ? mod_ctx : mod_lat;
#pragma unroll
        for (int j = 0; j < 8; ++j) { const int idx = (F.lane + 64 * j) * 4;
            const f32x4 gg = *(const GAS f32x4*)(g + idx), bb = *(const GAS f32x4*)(b + idx);
            const f32x4 xn = v[j] * rstd * gg + bb;
            if (fin) { *(GAS f32x4*)(fin + (size_t)row * DM + idx) = xn; }
            else { *(GAS f32x4*)(xr + idx) = xn;
                const f32x4 sh = *(const GAS f32x4*)(mod + ish * DM + idx), sc = *(const GAS f32x4*)(mod + isc * DM + idx);
                const f32x4 o = xn * (sc + 1.0f) + sh;
                *(GAS unsigned long long*)(((bf16*)(F.ws + WS_XM)) + (size_t)row * DM + idx) = (unsigned long long)cvt2(o[0], o[1]) | ((unsigned long long)cvt2(o[2], o[3]) << 32); } }
    }
}

typedef float f32x16 __attribute__((ext_vector_type(16)));
typedef short s16x4 __attribute__((ext_vector_type(4)));
typedef short v4i16_t __attribute__((ext_vector_type(4)));
__device__ __forceinline__ int crow(int i, int h) { return (i & 3) + 8 * (i >> 2) + 4 * h; }
__device__ __forceinline__ s16x4 vtr(LAS const unsigned char* p) { return __builtin_bit_cast(s16x4, __builtin_amdgcn_ds_read_tr16_b64_v4i16((LAS v4i16_t*)p)); }
#define MFMA32(a, b, c) __builtin_amdgcn_mfma_f32_32x32x16_bf16((a), (b), (c), 0, 0, 0)
constexpr int L_K = 0, L_V = 17408, L_CMB = 40960, L_BIAS = 106496;

template <int MODE>
__device__ __forceinline__ void attn_unit(Frame& F, const Args& A, int uidx, bool is_ctx, int layer) {
    constexpr int KD = (MODE == 0) ? 128 : 64, NCH = KD / 64, KP = KD * 2 + 16, VP = KD * 2 + 64, NEB = KD / 32;
    const int tid = F.tid, lane = F.lane, w = F.wave, r = lane & 31, h = lane >> 5;
    LAS unsigned char* lds = F.lds + RING_OFF;
    const bf16* PROJ = ((bf16*)(F.ws + WS_PROJ));
    int qrow, qcol, kcol0, vcol0, kcl = 0, nctx, nb0, nt, ocol;
    int gr = 0, my_rs = 0, sub = 0;
    float sink2 = 0.f;
    if (MODE == 0) {
        const int head = uidx & 3, qb = uidx >> 2; sub = w >> 1; const int comp = w & 1;
        qrow = (is_ctx ? SEQ : 0) + 128 * qb + 32 * sub; qcol = C_AQ + 128 * head + 64 * comp; kcol0 = C_AK + 128 * head; vcol0 = C_AV + 128 * head; kcl = 64 * comp;
        if (is_ctx) { nctx = 4; nb0 = 0; nt = 4; } else { nctx = 0; nb0 = 0; nt = MTOT / 64; }
        ocol = 128 * head;
    } else if (MODE == 1) {
        const int kv = uidx & 1, qb = uidx >> 1; const int g = w >> 1; sub = w & 1; const int head = 4 * kv + g;
        qrow = (is_ctx ? SEQ : 0) + 64 * qb + 32 * sub; qcol = C_CQ + 64 * head; kcol0 = C_CK + 64 * kv; vcol0 = C_CV + 64 * kv;
        nctx = 4;
        if (is_ctx) { nb0 = 0; nt = 4; } else { const int b0 = qb - 2 < 0 ? 0 : qb - 2, b1 = qb + 2 > 255 ? 255 : qb + 2; nb0 = b0; nt = 4 + (b1 - b0 + 1); }
        ocol = 1024 + 64 * head;
        sink2 = A.in[19][layer * 8 + head] * LOG2E;
    } else {
        const int head = uidx & 7, rg = uidx >> 3;
        qcol = C_DQ + 64 * head; kcol0 = C_DK + 64 * head; vcol0 = C_DV + 64 * head; nctx = 4; ocol = 1536 + 64 * head;
        if (is_ctx) { qrow = SEQ + 32 * w; nb0 = 0; nt = 4; }
        else { gr = 4 * rg + (w >> 1); qrow = 64 * gr + 32 * (w & 1);
            int lo = 4 * rg - 4; lo = lo < 0 ? 0 : (lo > 248 ? 248 : lo); int hi = 4 * rg + 3 - 4; hi = hi < 0 ? 0 : (hi > 248 ? 248 : hi); hi += 7;
            nb0 = lo; nt = 4 + (hi - lo + 1); my_rs = gr - 4; my_rs = my_rs < 0 ? 0 : (my_rs > 248 ? 248 : my_rs);
            LAS float* bl = (LAS float*)(lds + L_BIAS);
            for (int i = tid; i < 15 * 31; i += NTHREADS) bl[i] = A.in[20][(size_t)(layer * 8 + head) * 465 + i] * LOG2E; }
    }
    bf16x8 qf[4];
#pragma unroll
    for (int s = 0; s < 4; ++s) qf[s] = *(const GAS bf16x8*)(PROJ + (size_t)(qrow + r) * DPROJ + qcol + 16 * s + 8 * h);
    f32x16 o[NEB];
#pragma unroll
    for (int e = 0; e < NEB; ++e)
#pragma unroll
        for (int i = 0; i < 16; ++i) o[e][i] = 0.f;
    float m_run = -1e30f, l_run = 0.f;
    v4u kreg[NCH], vreg[NCH];
#define TILE_ROW(t) (((t) < nctx) ? (SEQ + 64 * (t)) : 64 * (nb0 + (t) - nctx))
#define TILE_GLOAD(t) do { const int rb_ = TILE_ROW(t); _Pragma("unroll") for (int i_ = 0; i_ < NCH; ++i_) { const int c_ = tid + NTHREADS * i_, row_ = c_ / (KD / 8), cc_ = c_ % (KD / 8); \
        kreg[i_] = *(const GAS v4u*)(PROJ + (size_t)(rb_ + row_) * DPROJ + kcol0 + 8 * cc_); vreg[i_] = *(const GAS v4u*)(PROJ + (size_t)(rb_ + row_) * DPROJ + vcol0 + 8 * cc_); } } while (0)
#define TILE_LSTORE() do { _Pragma("unroll") for (int i_ = 0; i_ < NCH; ++i_) { const int c_ = tid + NTHREADS * i_, row_ = c_ / (KD / 8), cc_ = c_ % (KD / 8); \
        *(LAS v4u*)(lds + L_K + row_ * KP + cc_ * 16) = kreg[i_]; *(LAS v4u*)(lds + L_V + row_ * VP + cc_ * 16) = vreg[i_]; } } while (0)
    TILE_GLOAD(0);
    const int li = lane & 15, lblk = (lane >> 4) & 1;
    for (int t = 0; t < nt; ++t) {
        __syncthreads();
        TILE_LSTORE();
        __syncthreads();
        if (t + 1 < nt) TILE_GLOAD(t + 1);
        bool active = true;
        int kr = 0;
        if (MODE == 2 && t >= nctx) { kr = nb0 + t - nctx; active = (kr >= my_rs) && (kr <= my_rs + 7); }
        if (active) {
            f32x16 s0, s1;
#pragma unroll
            for (int i = 0; i < 16; ++i) { s0[i] = 0.f; s1[i] = 0.f; }
#pragma unroll
            for (int s = 0; s < 4; ++s) {
                const bf16x8 k0 = *(const LAS bf16x8*)(lds + L_K + r * KP + (kcl + 16 * s + 8 * h) * 2);
                const bf16x8 k1 = *(const LAS bf16x8*)(lds + L_K + (32 + r) * KP + (kcl + 16 * s + 8 * h) * 2);
                s0 = MFMA32(k0, qf[s], s0); s1 = MFMA32(k1, qf[s], s1);
            }
            if (MODE == 1 && t >= nctx) {
                const int rb = TILE_ROW(t), qt = qrow + r;
#pragma unroll
                for (int i = 0; i < 16; ++i) { const int k0t = rb + crow(i, h), d0 = k0t - qt, d1 = d0 + 32;
                    if (d0 > 128 || d0 < -128) s0[i] = -INFINITY; if (d1 > 128 || d1 < -128) s1[i] = -INFINITY; }
            }
            if (MODE == 2 && t >= nctx) {
                const int qc = (qrow & 63) + r; int cs = qc - 8; cs = cs < 0 ? 0 : (cs > 48 ? 48 : cs);
                const LAS float* bl = (const LAS float*)(lds + L_BIAS) + (kr - gr + 7) * 31 + 15 - qc;
#pragma unroll
                for (int i = 0; i < 16; ++i) { const int kc0 = crow(i, h), kc1 = kc0 + 32;
                    s0[i] = (kc0 >= cs && kc0 < cs + 16) ? s0[i] + bl[kc0] : -INFINITY;
                    s1[i] = (kc1 >= cs && kc1 < cs + 16) ? s1[i] + bl[kc1] : -INFINITY; }
            }
            float mx = s0[0];
#pragma unroll
            for (int i = 1; i < 16; ++i) mx = fmaxf(mx, s0[i]);
#pragma unroll
            for (int i = 0; i < 16; ++i) mx = fmaxf(mx, s1[i]);
            mx = fmaxf(mx, __shfl_xor(mx, 32));
            const float m_new = fmaxf(m_run, mx), alpha = __builtin_amdgcn_exp2f(m_run - m_new);
            m_run = m_new;
            float ls = 0.f;
#pragma unroll
            for (int i = 0; i < 16; ++i) { s0[i] = __builtin_amdgcn_exp2f(s0[i] - m_new); s1[i] = __builtin_amdgcn_exp2f(s1[i] - m_new); ls += s0[i] + s1[i]; }
            l_run = l_run * alpha + ls;
#pragma unroll
            for (int e = 0; e < NEB; ++e)
#pragma unroll
                for (int i = 0; i < 16; ++i) o[e][i] *= alpha;
            bf16x8 pf[2][2];
#pragma unroll
            for (int s = 0; s < 2; ++s) {
                v4u a, b;
                a.x = cvt2(s0[8 * s + 0], s0[8 * s + 1]); a.y = cvt2(s0[8 * s + 2], s0[8 * s + 3]); a.z = cvt2(s0[8 * s + 4], s0[8 * s + 5]); a.w = cvt2(s0[8 * s + 6], s0[8 * s + 7]);
                b.x = cvt2(s1[8 * s + 0], s1[8 * s + 1]); b.y = cvt2(s1[8 * s + 2], s1[8 * s + 3]); b.z = cvt2(s1[8 * s + 4], s1[8 * s + 5]); b.w = cvt2(s1[8 * s + 6], s1[8 * s + 7]);
                pf[0][s] = __builtin_bit_cast(bf16x8, a); pf[1][s] = __builtin_bit_cast(bf16x8, b);
            }
#pragma unroll
            for (int kb = 0; kb < 2; ++kb)
#pragma unroll
                for (int s = 0; s < 2; ++s)
#pragma unroll
                    for (int e = 0; e < NEB; ++e) {
                        LAS const unsigned char* vp = lds + L_V + (32 * kb + 16 * s + 4 * h + (li >> 2)) * VP + (32 * e + 16 * lblk) * 2 + 8 * (li & 3);
                        const s16x4 lo = vtr(vp), hi = vtr(vp + 8 * VP);
                        const bf16x8 vf = {lo[0], lo[1], lo[2], lo[3], hi[0], hi[1], hi[2], hi[3]};
                        o[e] = MFMA32(vf, pf[kb][s], o[e]);
                    }
        }
    }
#undef TILE_ROW
#undef TILE_GLOAD
#undef TILE_LSTORE
    float l_tot = l_run + __shfl_xor(l_run, 32);
    if (MODE == 1) l_tot += __builtin_amdgcn_exp2f(sink2 - m_run);
    const float inv = 1.0f / l_tot;
#pragma unroll
    for (int e = 0; e < NEB; ++e)
#pragma unroll
        for (int i = 0; i < 16; ++i) o[e][i] *= inv;
    bf16* Y = ((bf16*)(F.ws + WS_YCAT)) + (size_t)(qrow + r) * DM + ocol;
    if (MODE == 0) {
        LAS float* cmb = (LAS float*)(lds + L_CMB) + (size_t)sub * 64 * 64;
        __syncthreads();
        if (w & 1) {
#pragma unroll
            for (int e = 0; e < NEB; ++e)
#pragma unroll
                for (int i = 0; i < 16; ++i) cmb[(e * 16 + i) * 64 + lane] = o[e][i];
        }
        __syncthreads();
        if (!(w & 1)) {
            const float lam = ((float*)(F.ws + WS_LAM))[layer * 4 + 0], oml = ((float*)(F.ws + WS_LAM))[layer * 4 + 1];
            float ss = 0.f;
#pragma unroll
            for (int e = 0; e < NEB; ++e)
#pragma unroll
                for (int i = 0; i < 16; ++i) { const float d = o[e][i] - lam * cmb[(e * 16 + i) * 64 + lane]; o[e][i] = d; ss += d * d; }
            ss += __shfl_xor(ss, 32);
            const float sc = oml / sqrtf(ss * (1.0f / 128.0f) + LN_EPS);
#pragma unroll
            for (int e = 0; e < NEB; ++e)
#pragma unroll
                for (int g = 0; g < 4; ++g)
                    *(GAS unsigned long long*)(Y + 32 * e + 8 * g + 4 * h) = (unsigned long long)cvt2(o[e][4 * g] * sc, o[e][4 * g + 1] * sc) | ((unsigned long long)cvt2(o[e][4 * g + 2] * sc, o[e][4 * g + 3] * sc) << 32);
        }
    } else {
#pragma unroll
        for (int e = 0; e < NEB; ++e)
#pragma unroll
            for (int g = 0; g < 4; ++g)
                *(GAS unsigned long long*)(Y + 32 * e + 8 * g + 4 * h) = (unsigned long long)cvt2(o[e][4 * g], o[e][4 * g + 1]) | ((unsigned long long)cvt2(o[e][4 * g + 2], o[e][4 * g + 3]) << 32);
    }
    __syncthreads();
}

__device__ __forceinline__ void bmix_unit(Frame& F, const Args& A, int n, int layer) {
    constexpr int VNP = 272;
    const int tid = F.tid, lane = F.lane, w = F.wave, r = lane & 31, h = lane >> 5;
    LAS unsigned char* lds = F.lds + RING_OFF;
    LAS float* stats = (LAS float*)(lds + 36864);
    const bf16* PROJ = ((bf16*)(F.ws + WS_PROJ)); const int row0 = 128 * n;
    const float* gng = A.in[15] + layer * 512; const float* gnb = A.in[16] + layer * 512;
    __syncthreads();
    for (int rr = 0; rr < 16; ++rr) {
        const v4u p = *(const GAS v4u*)(PROJ + (size_t)(row0 + 16 * w + rr) * DPROJ + C_BV + 8 * lane);
        float v[8] = {bf_lo(p.x), bf_hi(p.x), bf_lo(p.y), bf_hi(p.y), bf_lo(p.z), bf_hi(p.z), bf_lo(p.w), bf_hi(p.w)};
        float s = 0.f;
#pragma unroll
        for (int i = 0; i < 8; ++i) s += v[i];
        const float mean = wave_sum(s) * (1.0f / 512.0f); float s2 = 0.f;
#pragma unroll
        for (int i = 0; i < 8; ++i) { const float d = v[i] - mean; s2 += d * d; }
        const float rstd = 1.0f / sqrtf(wave_sum(s2) * (1.0f / 512.0f) + LN_EPS);
        if (lane == 0) { stats[(16 * w + rr) * 2] = mean; stats[(16 * w + rr) * 2 + 1] = rstd; }
    }
    __syncthreads();
    for (int g = 0; g < 4; ++g) {
        { const int q = tid & 127, cg = tid >> 7; const float mean = stats[q * 2], rstd = stats[q * 2 + 1];
#pragma unroll
          for (int i4 = 0; i4 < 4; ++i4) {
            const int cb = 128 * g + 32 * cg + 8 * i4;
            const v4u p = *(const GAS v4u*)(PROJ + (size_t)(row0 + q) * DPROJ + C_BV + cb);
            const float v[8] = {bf_lo(p.x), bf_hi(p.x), bf_lo(p.y), bf_hi(p.y), bf_lo(p.z), bf_hi(p.z), bf_lo(p.w), bf_hi(p.w)};
#pragma unroll
            for (int i = 0; i < 8; ++i) { const float y = (v[i] - mean) * rstd * gng[cb + i] + gnb[cb + i];
                *(LAS bf16*)(lds + (32 * cg + 8 * i4 + i) * VNP + 2 * q) = (bf16)f2bf(y); }
          } }
        __syncthreads();
        const int pb = w & 3; const bf16* Wg = ((bf16*)(F.ws + WS_WSP)) + (size_t)(layer * 4 + g) * 128 * 128;
        f32x16 d[2];
#pragma unroll
        for (int j = 0; j < 2; ++j)
#pragma unroll
            for (int i = 0; i < 16; ++i) d[j][i] = 0.f;
#pragma unroll
        for (int s = 0; s < 8; ++s) {
            const bf16x8 bw = *(const GAS bf16x8*)(Wg + (size_t)(32 * pb + r) * 128 + 16 * s + 8 * h);
#pragma unroll
            for (int j = 0; j < 2; ++j) { const int cb = 2 * (w >> 2) + j;
                const bf16x8 av = *(const LAS bf16x8*)(lds + (32 * cb + r) * VNP + (16 * s + 8 * h) * 2);
                d[j] = MFMA32(av, bw, d[j]); }
        }
        const int row = row0 + 32 * pb + r; const float bsv = A.in[18][(size_t)(layer * 4 + g) * 128 + 32 * pb + r];
#pragma unroll
        for (int j = 0; j < 2; ++j) { const int cb = 2 * (w >> 2) + j;
#pragma unroll
            for (int gq = 0; gq < 4; ++gq) { const int c = 128 * g + 32 * cb + 8 * gq + 4 * h;
                const unsigned long long up = *(const GAS unsigned long long*)(PROJ + (size_t)row * DPROJ + C_BU + c);
                const unsigned ulo = (unsigned)up, uhi = (unsigned)(up >> 32);
                const float o0 = bf_lo(ulo) * (d[j][4 * gq] + bsv), o1 = bf_hi(ulo) * (d[j][4 * gq + 1] + bsv), o2 = bf_lo(uhi) * (d[j][4 * gq + 2] + bsv), o3 = bf_hi(uhi) * (d[j][4 * gq + 3] + bsv);
                *(GAS unsigned long long*)(((bf16*)(F.ws + WS_YCAT)) + (size_t)row * DM + 512 + c) = (unsigned long long)cvt2(o0, o1) | ((unsigned long long)cvt2(o2, o3) << 32); } }
        __syncthreads();
    }
}

__device__ __forceinline__ void attnA_unit(Frame& F, const Args& A, int uidx, bool is_ctx, int layer) {
    const int lane = F.lane, w = F.wave, r = lane & 31, h = lane >> 5, li = lane & 15, lblk = (lane >> 4) & 1;
    LAS unsigned char* lds = F.lds + RING_OFF;
    const bf16* PROJ = ((bf16*)(F.ws + WS_PROJ));
    const int head = uidx & 3, qb = uidx >> 2, comp = w & 1, sub = w >> 1;
    const int row00 = is_ctx ? SEQ : 0, nt = is_ctx ? 4 : MTOT / 64;
    const int qrow0 = row00 + 256 * qb + 64 * sub;
    const int qcol = C_AQ + 128 * head + 64 * comp, kcol0 = C_AK + 128 * head, vcol0 = C_AV + 128 * head;
    bf16x8 qf[2][4];
#pragma unroll
    for (int j = 0; j < 2; ++j)
#pragma unroll
        for (int s = 0; s < 4; ++s) qf[j][s] = *(const GAS bf16x8*)(PROJ + (size_t)(qrow0 + 32 * j + r) * DPROJ + qcol + 16 * s + 8 * h);
    unsigned dk0;
    { const int R = 4 * w + (lane >> 4), fR = ((R & 7) << 1) | ((R >> 3) & 1), c = (lane & 15) ^ fR; dk0 = (unsigned)((R * DPROJ + kcol0) * 2 + 16 * c); }
    int ka[4]; unsigned vaL[4], vaH[4];
    { const int fr = ((r & 7) << 1) | ((r >> 3) & 1), cbx = (8 * comp + h) ^ fr;
#pragma unroll
      for (int s = 0; s < 4; ++s) ka[s] = r * 256 + 16 * (cbx ^ (2 * s));
      const int lp = (2 * lblk + ((li & 3) >> 1)) ^ (8 * h + 2 * (li >> 2));
#pragma unroll
      for (int e = 0; e < 4; ++e)
          { const int v_ = 16384 + (4 * h + (li >> 2)) * 256 + 16 * (lp ^ (4 * e)) + 8 * (li & 1); vaL[e] = (unsigned)(uintptr_t)(lds + v_); vaH[e] = (unsigned)(uintptr_t)(lds + (v_ ^ 16)); } }
    f32x16 o[2][4];
#pragma unroll
    for (int j = 0; j < 2; ++j)
#pragma unroll
        for (int e = 0; e < 4; ++e)
#pragma unroll
            for (int i = 0; i < 16; ++i) o[j][e][i] = 0.f;
    float mref[2] = {0.f, 0.f}, lsum[2] = {0.f, 0.f}, thr[2] = {-3.0e38f, -3.0e38f};
#define A_DMA(t, b) do { const char* gb_ = (const char*)PROJ + (size_t)(row00 + 64 * (t)) * (DPROJ * 2); _Pragma("unroll") for (int i_ = 0; i_ < 2; ++i_) { \
        __builtin_amdgcn_global_load_lds((const unsigned*)(gb_ + dk0 + i_ * (32 * DPROJ * 2)), (LAS unsigned*)(lds + (b) * 32768 + (w + 8 * i_) * 1024), 16, 0, 0); \
        __builtin_amdgcn_global_load_lds((const unsigned*)(gb_ + dk0 + i_ * (32 * DPROJ * 2) + 1024), (LAS unsigned*)(lds + (b) * 32768 + 16384 + (w + 8 * i_) * 1024), 16, 0, 0); } } while (0)
#define A_TRR(dst, addr, off) asm volatile("ds_read_b64_tr_b16 %0, %1 offset:%c2" : "=&v"(dst) : "v"(addr), "i"(off) : "memory")
#define A_SYNC() do { asm volatile("s_waitcnt vmcnt(0)" ::: "memory"); __builtin_amdgcn_s_barrier(); asm volatile("" ::: "memory"); } while (0)
#define A_COMPUTE(b) do { _Pragma("unroll") for (int kb = 0; kb < 2; ++kb) { \
        bf16x8 pf[2][2]; \
        _Pragma("unroll") for (int j = 0; j < 2; ++j) { __builtin_amdgcn_sched_barrier(0); \
            f32x16 s_; _Pragma("unroll") for (int i = 0; i < 16; ++i) s_[i] = -mref[j]; \
            _Pragma("unroll") for (int s = 0; s < 4; ++s) { const bf16x8 kf = *(const LAS bf16x8*)(lds + (b) * 32768 + kb * 8192 + ka[s]); s_ = MFMA32(kf, qf[j][s], s_); } \
            float mx = fmaxf(fmaxf(s_[0], s_[1]), s_[2]); \
            _Pragma("unroll") for (int i = 3; i < 15; i += 2) mx = fmaxf(fmaxf(mx, s_[i]), s_[i + 1]); \
            mx = fmaxf(mx, s_[15]); mx = fmaxf(mx, __shfl_xor(mx, 32)); \
            if (__any(mx > thr[j])) { const float d = mx > thr[j] ? mx : 0.f, al = __builtin_amdgcn_exp2f(-d); mref[j] += d; lsum[j] *= al; \
                _Pragma("unroll") for (int i = 0; i < 16; ++i) s_[i] -= d; \
                _Pragma("unroll") for (int e = 0; e < 4; ++e) _Pragma("unroll") for (int i = 0; i < 16; ++i) o[j][e][i] *= al; } \
            thr[j] = 8.0f; float ls = 0.f; \
            _Pragma("unroll") for (int i = 0; i < 16; ++i) { s_[i] = __builtin_amdgcn_exp2f(s_[i]); ls += s_[i]; } \
            lsum[j] += ls; \
            _Pragma("unroll") for (int s = 0; s < 2; ++s) { v4u a_; a_.x = cvt2(s_[8 * s + 0], s_[8 * s + 1]); a_.y = cvt2(s_[8 * s + 2], s_[8 * s + 3]); a_.z = cvt2(s_[8 * s + 4], s_[8 * s + 5]); a_.w = cvt2(s_[8 * s + 6], s_[8 * s + 7]); \
                pf[j][s] = __builtin_bit_cast(bf16x8, a_); } } \
        __builtin_amdgcn_sched_barrier(0); \
        _Pragma("unroll") for (int s = 0; s < 2; ++s) _Pragma("unroll") for (int eh = 0; eh < 2; ++eh) { s16x4 lo_[2], hi_[2]; \
            _Pragma("unroll") for (int e = 0; e < 2; ++e) { A_TRR(lo_[e], vaL[2 * eh + e], (b) * 32768 + kb * 8192 + s * 4096); A_TRR(hi_[e], vaH[2 * eh + e], (b) * 32768 + kb * 8192 + s * 4096 + 2048); } \
            asm volatile("s_waitcnt lgkmcnt(0)" ::: "memory"); __builtin_amdgcn_sched_barrier(0); \
            _Pragma("unroll") for (int e = 0; e < 2; ++e) { const bf16x8 vf = {lo_[e][0], lo_[e][1], lo_[e][2], lo_[e][3], hi_[e][0], hi_[e][1], hi_[e][2], hi_[e][3]}; \
                o[0][2 * eh + e] = MFMA32(vf, pf[0][s], o[0][2 * eh + e]); o[1][2 * eh + e] = MFMA32(vf, pf[1][s], o[1][2 * eh + e]); } \
            __builtin_amdgcn_sched_barrier(0); } } } while (0)
    A_DMA(0, 0); A_SYNC();
    for (int t = 0; t < nt; t += 2) {
        A_DMA(t + 1, 1);
        A_COMPUTE(0);
        A_SYNC();
        if (t + 2 < nt) A_DMA(t + 2, 0);
        A_COMPUTE(1);
        A_SYNC();
    }
#undef A_DMA
#undef A_COMPUTE
#undef A_TRR
    const float lam = ((float*)(F.ws + WS_LAM))[layer * 4 + 0], oml = ((float*)(F.ws + WS_LAM))[layer * 4 + 1];
    LAS float* cmb = (LAS float*)lds + (size_t)sub * 64 * 64;
#pragma unroll
    for (int j = 0; j < 2; ++j) {
        const float lt = lsum[j] + __shfl_xor(lsum[j], 32), inv = 1.0f / lt;
        if (comp) {
#pragma unroll
            for (int e = 0; e < 4; ++e)
#pragma unroll
                for (int i = 0; i < 16; ++i) cmb[(e * 16 + i) * 64 + lane] = o[j][e][i] * inv;
        }
        __syncthreads();
        if (!comp) {
            float ss = 0.f;
#pragma unroll
            for (int e = 0; e < 4; ++e)
#pragma unroll
                for (int i = 0; i < 16; ++i) { const float d = o[j][e][i] * inv - lam * cmb[(e * 16 + i) * 64 + lane]; o[j][e][i] = d; ss += d * d; }
            ss += __shfl_xor(ss, 32);
            const float sc = oml / sqrtf(ss * (1.0f / 128.0f) + LN_EPS);
            bf16* Y = ((bf16*)(F.ws + WS_YCAT)) + (size_t)(qrow0 + 32 * j + r) * DM + 128 * head;
#pragma unroll
            for (int e = 0; e < 4; ++e)
#pragma unroll
                for (int g = 0; g < 4; ++g)
                    *(GAS unsigned long long*)(Y + 32 * e + 8 * g + 4 * h) = (unsigned long long)cvt2(o[j][e][4 * g] * sc, o[j][e][4 * g + 1] * sc) | ((unsigned long long)cvt2(o[j][e][4 * g + 2] * sc, o[j][e][4 * g + 3] * sc) << 32);
        }
        __syncthreads();
    }
#undef A_SYNC
}

#ifndef MK_DUP
#define MK_DUP 0
#endif
#ifndef MK_SINGLE
#define MK_SINGLE 1
#endif
constexpr int N_PHASES = 2 + 8 * 3 + 4 * 4;
__global__ void __launch_bounds__(NTHREADS, 2) mega_fwd(Args args) {
    extern __shared__ __attribute__((aligned(16))) unsigned char lds_raw[];
    Frame F;
    F.lds = (LAS unsigned char*)lds_raw;
    const int wave0 = __builtin_amdgcn_readfirstlane((int)threadIdx.x >> 6);
#define PH_BEGIN() do { int w_ = wave0; asm volatile("" : "+s"(w_)); int l_ = (int)__builtin_amdgcn_mbcnt_hi(~0u, __builtin_amdgcn_mbcnt_lo(~0u, 0u)); asm volatile("" : "+v"(l_)); F.wave = w_; F.lane = l_; F.tid = w_ * 64 + l_; \
        int b_ = (int)blockIdx.x; asm volatile("" : "+s"(b_)); F.bid = b_; F.gw = b_ * NWAVES + w_; unsigned char* p_ = args.ws; asm volatile("" : "+s"(p_)); F.ws = p_; } while (0)
    F.G = gridDim.x; F.ngw = F.G * NWAVES;
    PH_BEGIN();
    const Args& A = args;
    for (int u = F.tid; u < (LDS_BYTES - LDSCTL_OFF) / 4; u += NTHREADS) ((LAS unsigned*)(F.lds + LDSCTL_OFF))[u] = 0u;
    __syncthreads();
    const int lo = args.ph_lo, hi = args.ph_hi;
    const bool multi = (hi - lo) > 1;
    XcdBarrier bar; bar.bar = (unsigned*)(F.ws + WS_CTL) + CW_BAR; bar.x = 0; bar.st = nullptr;
    if (multi) bar = xcd_barrier_post((unsigned*)(F.ws + WS_CTL) + CW_BAR, (volatile LAS unsigned*)(F.lds + MISC_OFF) + 8);
    int pc = 0;
#define IN_PH() (lo <= pc && pc < hi)
#define SEAM() do { if (lo <= pc && pc + 1 < hi) xcd_barrier(bar); ++pc; } while (0)
#define WSF(off) ((float*)(F.ws + (off)))
#define WSB(off) ((bf16*)(F.ws + (off)))

    if (IN_PH()) { PH_BEGIN(); asm volatile("; MARK1" ::: "memory"); p0a(F, A);
#if MK_DUP == 3
        __syncthreads(); PH_BEGIN(); p0a(F, A);
#endif
    } SEAM();
    if (IN_PH()) { PH_BEGIN(); asm volatile("; MARK2" ::: "memory"); p0b(F, A); } SEAM();

    for (int seg = 0; seg < 2 * NLAYER; ++seg) {
        const int l = seg >> 1, second = seg & 1; const bool last = (l == NLAYER - 1);
        const int mrows = (last && second) ? SEQ : MTOT;
#define WL() (WSB(WS_W) + (size_t)l * (W_LAYER / 2))
#define MOD_LAT() (WSF(WS_MOD) + (size_t)(l * 2 + 0) * MODW)
#define MOD_CTX() (WSF(WS_MOD) + (size_t)(l * 2 + 1) * MODW)
        if (IN_PH()) { PH_BEGIN(); asm volatile("; MARK3" ::: "memory");
            pg8::Gemm g{WSB(WS_XM), WL() + (second ? W_2IN : W_1IN) / 2, mrows, 2 * DFF, DM}; pg8::StaticOrder S; S.init(mrows, 2 * DFF, F.G, F.bid);
            pg8::EpiSwiGLU E{WSB(WS_H), DFF};
            pg8::gemm_phase<pg8::EpiSwiGLU, pg8::StaticOrder, true, true>(F.lds + RING_OFF, g, S, E, F.tid);
#if MK_DUP == 1
            __syncthreads(); PH_BEGIN();
            pg8::gemm_phase<pg8::EpiSwiGLU, pg8::StaticOrder, true, true>(F.lds + RING_OFF, g, S, E, F.tid);
#endif
        } SEAM();
        if (IN_PH()) { PH_BEGIN(); asm volatile("; MARK4" ::: "memory");
            pg8::Gemm g{WSB(WS_H), WL() + (second ? W_2OUT : W_1OUT) / 2, mrows, DM, DFF}; pg8::StaticOrder S; S.init(mrows, DM, F.G, F.bid);
            const int gi = second ? 8 : 2;
            pg8::EpiRes E{WSF(WS_X), DM, MOD_LAT() + gi * DM, MOD_CTX() + gi * DM, 0.5f, ALPHA, SEQ / 256};
            pg8::gemm_phase<pg8::EpiRes, pg8::StaticOrder, true, true>(F.lds + RING_OFF, g, S, E, F.tid);
        } SEAM();
        if (IN_PH()) { PH_BEGIN(); asm volatile("; MARK5" ::: "memory");
            const int lni = second ? 2 : 0;
            const float* g = A.in[6] + (size_t)(l * 3 + lni) * DM; const float* b = A.in[7] + (size_t)(l * 3 + lni) * DM;
            const bool fin = second && last;
            const int lm = (second && !last) ? l + 1 : l;
            ln_pass(F, A, g, b, WSF(WS_MOD) + (size_t)(lm * 2) * MODW, WSF(WS_MOD) + (size_t)(lm * 2 + 1) * MODW, second ? 0 : 3, second ? 1 : 4, mrows, fin ? A.out : nullptr);
#if MK_DUP == 4
            if (!fin) { PH_BEGIN(); ln_pass(F, A, g, b, WSF(WS_MOD), WSF(WS_MOD), 0, 1, mrows, WSF(WS_END)); }
#endif
        } SEAM();
        if (!second) {
            if (IN_PH()) { PH_BEGIN(); asm volatile("; MARK6" ::: "memory");
                pg8::Gemm g{WSB(WS_XM), WL() + W_MI / 2, MTOT, DPROJ, DM}; pg8::StaticOrder S; S.init(MTOT, DPROJ, F.G, F.bid);
                pg8::EpiProj E{WSB(WS_PROJ), DPROJ, WSF(WS_ROPE), WSF(WS_ROPE) + 4096, WSF(WS_ROPE) + 8192, WSF(WS_ROPE) + 9216, SEQ, QS};
                pg8::gemm_phase<pg8::EpiProj, pg8::StaticOrder, true, true>(F.lds + RING_OFF, g, S, E, F.tid);
            } SEAM();
            if (IN_PH()) { PH_BEGIN(); asm volatile("; MARK7" ::: "memory");
                const int n_lat = 256 + 512 * 2 + 128, n_all = last ? n_lat : n_lat + 22;
#if MK_DUP == 2 || MK_DUP == 6
                for (int rep = 0; rep < 2; ++rep)
#endif
                for (int u = F.bid; u < n_all; u += F.G) { PH_BEGIN();
#if MK_DUP == 6
                    if (rep == 1 && u >= 256) continue;
#endif
                    int mode, ui; bool cx = false;
                    if (u < 256) { mode = 0; ui = u; } else if (u < 768) { mode = 1; ui = u - 256; } else if (u < 1280) { mode = 2; ui = u - 768; } else if (u < 1408) { mode = 3; ui = u - 1280; }
                    else if (u < 1412) { mode = 0; ui = u - 1408; cx = true; } else if (u < 1420) { mode = 1; ui = u - 1412; cx = true; } else if (u < 1428) { mode = 2; ui = u - 1420; cx = true; } else { mode = 3; ui = 128 + (u - 1428); }
                    if (mode == 0) attnA_unit(F, A, ui, cx, l);
                    else if (mode == 1) attn_unit<1>(F, A, ui, cx, l);
                    else if (mode == 2) attn_unit<2>(F, A, ui, cx, l);
                    else bmix_unit(F, A, ui, l);
                }
            } SEAM();
            { const int mr2 = last ? SEQ : MTOT;
            if (IN_PH()) { PH_BEGIN(); asm volatile("; MARK8" ::: "memory");
                pg8::Gemm g{WSB(WS_YCAT), WL() + W_MO / 2, mr2, DM, DM}; pg8::StaticOrder S; S.init(mr2, DM, F.G, F.bid);
                pg8::EpiRes E{WSF(WS_X), DM, MOD_LAT() + 5 * DM, MOD_CTX() + 5 * DM, 1.0f, ALPHA, SEQ / 256};
                pg8::gemm_phase<pg8::EpiRes, pg8::StaticOrder, true, true>(F.lds + RING_OFF, g, S, E, F.tid);
            } SEAM();
            if (IN_PH()) { PH_BEGIN(); asm volatile("; MARK9" ::: "memory");
                const float* g = A.in[6] + (size_t)(l * 3 + 1) * DM; const float* b = A.in[7] + (size_t)(l * 3 + 1) * DM;
                ln_pass(F, A, g, b, MOD_LAT(), MOD_CTX(), 6, 7, mr2, nullptr);
            } SEAM(); }
        }
    }
#undef IN_PH
#undef SEAM
}

extern "C" void kernel_launch(void* const* d_in, const int* in_sizes, int n_in, void* d_out, int out_size, void* d_ws, size_t ws_size, hipStream_t stream) {
    static int grid = 0;
    if (grid == 0) {
        if (n_in != 21 || in_sizes[0] != SEQ * DM || out_size != SEQ * DM || ws_size < WS_END) { fprintf(stderr, "kernel_launch: unexpected shapes (n_in %d, in0 %d, out %d, ws %zu); nothing launched\n", n_in, n_in > 0 ? in_sizes[0] : -1, out_size, ws_size); grid = -1; return; }
        int dev = 0, cus = 0, per_cu = 0;
        if (hipGetDevice(&dev) != hipSuccess || hipDeviceGetAttribute(&cus, hipDeviceAttributeMultiprocessorCount, dev) != hipSuccess) { grid = -1; return; }
        if (hipFuncSetAttribute((const void*)mega_fwd, hipFuncAttributeMaxDynamicSharedMemorySize, LDS_BYTES) != hipSuccess) { fprintf(stderr, "kernel_launch: hipFuncSetAttribute failed\n"); grid = -1; return; }
        if (hipOccupancyMaxActiveBlocksPerMultiprocessor(&per_cu, (const void*)mega_fwd, NTHREADS, LDS_BYTES) != hipSuccess || per_cu < 1) fprintf(stderr, "kernel_launch: occupancy query reports %d\n", per_cu);
        (void)hipGetLastError();
        grid = cus;
    }
    if (grid < 0) return;
    if (hipMemsetAsync((char*)d_ws + WS_CTL, 0, CTL_ZERO_BYTES, stream) != hipSuccess) return;
    Args a{};
    for (int i = 0; i < 21; ++i) a.in[i] = (const float*)d_in[i];
    a.out = (float*)d_out; a.ws = (unsigned char*)d_ws;
#if MK_SINGLE
    a.ph_lo = 0; a.ph_hi = N_PHASES;
    hipLaunchKernelGGL(mega_fwd, dim3(grid), dim3(NTHREADS), LDS_BYTES, stream, a);
#else
    for (int p = 0; p < N_PHASES; ++p) { a.ph_lo = p; a.ph_hi = p + 1; hipLaunchKernelGGL(mega_fwd, dim3(grid), dim3(NTHREADS), LDS_BYTES, stream, a); }
#endif
}
```
